# Optimizing an MI355X kernel written in HIP

```python
import jax, jax.numpy as jnp
from jax import lax
import numpy as np

D_MODEL = 2048
BATCH = 4
SEQ = 2048
DEPTH = 1

HEAD_DIM = 128
N_ATTN_HEADS = 8
ATTN_W = N_ATTN_HEADS * HEAD_DIM
DILATED_PATTERNS = ((128, 1), (512, 4), (2048, 16))
BAND_BLOCK = 128
N_GLA_HEADS = 4
GLA_DK = 128
GLA_DV = 256
GLA_KW = N_GLA_HEADS * GLA_DK
GLA_VW = N_GLA_HEADS * GLA_DV
GLA_GATE_RANK = 16
GLA_TAU = 16.0
GLA_CHUNK = 64
MIX_COLS = 3 * ATTN_W + 2 * GLA_KW + 2 * GLA_VW + GLA_GATE_RANK
N_MEM = 256
N_XATTN_HEADS = 4
XATTN_W = N_XATTN_HEADS * HEAD_DIM
D_FF = 5632
ROPE_THETA = 10000.0
EPS = 1e-6
NEG = -1e30

kernel_name = "hybrid_dilated_gla_macaron_layer"


def rms_norm(x, g):
    xf = x.astype(jnp.float32)
    y = xf * lax.rsqrt(jnp.mean(xf * xf, axis=-1, keepdims=True) + EPS)
    return (y * g.astype(jnp.float32)).astype(x.dtype)


def rope(x, pos):
    half = x.shape[-1] // 2
    inv = ROPE_THETA ** (-jnp.arange(half, dtype=jnp.float32) / half)
    ang = pos.astype(jnp.float32)[:, None] * inv[None, :]
    cos, sin = jnp.cos(ang), jnp.sin(ang)
    x1 = x[..., :half].astype(jnp.float32)
    x2 = x[..., half:].astype(jnp.float32)
    return jnp.concatenate([x1 * cos - x2 * sin, x2 * cos + x1 * sin], axis=-1).astype(x.dtype)


def swiglu(h, w_gate, w_up, w_down):
    return (jax.nn.silu(h @ w_gate) * (h @ w_up)) @ w_down


def banded_causal_attention(q, k, v, n_back):
    B, H, L, D = q.shape
    nb = -(-L // BAND_BLOCK)
    Lp = nb * BAND_BLOCK
    pad = ((0, 0), (0, 0), (0, Lp - L), (0, 0))
    qb = jnp.pad(q, pad).reshape(B, H, nb, BAND_BLOCK, D)
    kb = jnp.pad(k, pad).reshape(B, H, nb, BAND_BLOCK, D)
    vb = jnp.pad(v, pad).reshape(B, H, nb, BAND_BLOCK, D)
    prev = ((0, 0), (0, 0), (1, 0), (0, 0), (0, 0))
    k2 = jnp.concatenate([jnp.pad(kb, prev)[:, :, :-1], kb], axis=3)
    v2 = jnp.concatenate([jnp.pad(vb, prev)[:, :, :-1], vb], axis=3)
    s = jnp.einsum("bhnqd,bhnkd->bhnqk", qb, k2, preferred_element_type=jnp.float32)
    qi = jnp.arange(BAND_BLOCK)[:, None]
    kj = jnp.arange(2 * BAND_BLOCK)[None, :]
    dist = BAND_BLOCK + qi - kj
    blk = jnp.arange(nb)[:, None, None]
    valid = (dist >= 0) & (dist <= n_back) & ((blk > 0) | (kj >= BAND_BLOCK))
    s = jnp.where(valid, s, NEG)
    m = jnp.max(s, axis=-1, keepdims=True)
    p = jnp.exp(s - m)
    den = jnp.sum(p, axis=-1, keepdims=True)
    o = jnp.einsum("bhnqk,bhnkd->bhnqd", p, v2.astype(jnp.float32)) / den
    lse = (m + jnp.log(den))[..., 0]
    o = o.reshape(B, H, Lp, D)[:, :, :L]
    lse = lse.reshape(B, H, Lp)[:, :, :L]
    return o, lse


def dilated_attention(q, k, v):
    B, H, S, D = q.shape
    outs, lses = [], []
    for w, r in DILATED_PATTERNS:
        def to_cls(t):
            return t.reshape(B, H, S // r, r, D).transpose(0, 1, 3, 2, 4).reshape(B, H * r, S // r, D)
        o, l = banded_causal_attention(to_cls(q), to_cls(k), to_cls(v), w // r)
        outs.append(o.reshape(B, H, r, S // r, D).transpose(0, 1, 3, 2, 4).reshape(B, H, S, D))
        lses.append(l.reshape(B, H, r, S // r).transpose(0, 1, 3, 2).reshape(B, H, S))
    wts = jax.nn.softmax(jnp.stack(lses, axis=0), axis=0)
    return jnp.einsum("pbhs,pbhsd->bhsd", wts, jnp.stack(outs, axis=0))


def gla_chunked(q, k, v, log_a):
    B, H, S, dk = q.shape
    dv = v.shape[-1]
    n = S // GLA_CHUNK
    q = q.reshape(B, H, n, GLA_CHUNK, dk)
    k = k.reshape(B, H, n, GLA_CHUNK, dk)
    v = v.reshape(B, H, n, GLA_CHUNK, dv)
    b = jnp.cumsum(log_a.reshape(B, H, n, GLA_CHUNK, dk), axis=3)
    q_e = q * jnp.exp(b)
    k_e = k * jnp.exp(-b)
    causal = jnp.tril(jnp.ones((GLA_CHUNK, GLA_CHUNK), dtype=bool))
    A = jnp.where(causal, jnp.einsum("bhnid,bhnjd->bhnij", q_e, k_e), 0.0)
    o_intra = jnp.einsum("bhnij,bhnjd->bhnid", A, v)
    b_last = b[:, :, :, -1]
    k_dec = k * jnp.exp(b_last[:, :, :, None, :] - b)
    dS = jnp.einsum("bhncd,bhnce->bhnde", k_dec, v)

    def step(state, inp):
        decay, ds = inp
        return decay[..., None] * state + ds, state

    init = jnp.zeros((B, H, dk, dv), jnp.float32)
    _, s_before = lax.scan(step, init, (jnp.moveaxis(jnp.exp(b_last), 2, 0), jnp.moveaxis(dS, 2, 0)))
    s_before = jnp.moveaxis(s_before, 0, 2)
    o_inter = jnp.einsum("bhncd,bhnde->bhnce", q_e, s_before)
    return (o_intra + o_inter).reshape(B, H, S, dv)


def hybrid_mixer(h, pos, w_in, attn_q_norm, attn_k_norm, gla_w_gate2, gla_b_gate2, gla_out_norm, w_out):
    B, S, _ = h.shape
    proj = h @ w_in
    splits = np.cumsum([ATTN_W, ATTN_W, ATTN_W, GLA_KW, GLA_KW, GLA_VW, GLA_VW])
    qa, ka, va, qg, kg, vg, rg, glr = jnp.split(proj, splits, axis=-1)

    def heads(t, nh):
        return t.reshape(B, S, nh, -1).transpose(0, 2, 1, 3)

    qa = rope(rms_norm(heads(qa, N_ATTN_HEADS), attn_q_norm), pos) * (HEAD_DIM ** -0.5)
    ka = rope(rms_norm(heads(ka, N_ATTN_HEADS), attn_k_norm), pos)
    o_attn = dilated_attention(qa, ka, heads(va, N_ATTN_HEADS))
    o_attn = o_attn.transpose(0, 2, 1, 3).reshape(B, S, ATTN_W).astype(h.dtype)

    log_a = jax.nn.log_sigmoid((glr @ gla_w_gate2 + gla_b_gate2).astype(jnp.float32)) / GLA_TAU
    o_gla = gla_chunked(heads(qg, N_GLA_HEADS).astype(jnp.float32) * (GLA_DK ** -0.5),
                        heads(kg, N_GLA_HEADS).astype(jnp.float32),
                        heads(vg, N_GLA_HEADS).astype(jnp.float32),
                        heads(log_a, N_GLA_HEADS))
    o_gla = rms_norm(o_gla, gla_out_norm).transpose(0, 2, 1, 3).reshape(B, S, GLA_VW).astype(h.dtype)
    o_gla = o_gla * jax.nn.silu(rg)

    return jnp.concatenate([o_attn, o_gla], axis=-1) @ w_out


def cross_attention(h, m, w_q, w_k, w_v, q_norm, k_norm, w_o):
    B, S, _ = h.shape
    M = m.shape[1]
    q = rms_norm((h @ w_q).reshape(B, S, N_XATTN_HEADS, HEAD_DIM).transpose(0, 2, 1, 3), q_norm)
    k = rms_norm((m @ w_k).reshape(B, M, N_XATTN_HEADS, HEAD_DIM).transpose(0, 2, 1, 3), k_norm)
    v = (m @ w_v).reshape(B, M, N_XATTN_HEADS, HEAD_DIM).transpose(0, 2, 1, 3)
    s = jnp.einsum("bhqd,bhkd->bhqk", q, k, preferred_element_type=jnp.float32) * (HEAD_DIM ** -0.5)
    p = jax.nn.softmax(s, axis=-1)
    o = jnp.einsum("bhqk,bhkd->bhqd", p, v.astype(jnp.float32)).astype(h.dtype)
    return o.transpose(0, 2, 1, 3).reshape(B, S, XATTN_W) @ w_o


def setup_inputs(seed: int = 0) -> dict:
    key = jax.random.key(seed)
    ks = iter(jax.random.split(key, 32))
    L = DEPTH

    def w(shape, fan_in):
        return jax.random.normal(next(ks), shape, jnp.float32) * (fan_in ** -0.5)

    def gain(shape):
        return 1.0 + 0.02 * jax.random.normal(next(ks), shape, jnp.float32)

    return {
        "x": jax.random.normal(next(ks), (BATCH, SEQ, D_MODEL), jnp.float32),
        "mem": jax.random.normal(next(ks), (BATCH, N_MEM, D_MODEL), jnp.float32),
        "ffn1_norm": gain((L, D_MODEL)),
        "ffn1_w_gate": w((L, D_MODEL, D_FF), D_MODEL),
        "ffn1_w_up": w((L, D_MODEL, D_FF), D_MODEL),
        "ffn1_w_down": w((L, D_FF, D_MODEL), D_FF),
        "mix_norm": gain((L, D_MODEL)),
        "w_in": w((L, D_MODEL, MIX_COLS), D_MODEL),
        "attn_q_norm": gain((L, HEAD_DIM)),
        "attn_k_norm": gain((L, HEAD_DIM)),
        "gla_w_gate2": w((L, GLA_GATE_RANK, GLA_KW), GLA_GATE_RANK),
        "gla_b_gate2": 0.01 * jax.random.normal(next(ks), (L, GLA_KW), jnp.float32),
        "gla_out_norm": gain((L, GLA_DV)),
        "w_out": w((L, ATTN_W + GLA_VW, D_MODEL), ATTN_W + GLA_VW),
        "xattn_norm": gain((L, D_MODEL)),
        "mem_norm": gain((L, D_MODEL)),
        "xattn_w_q": w((L, D_MODEL, XATTN_W), D_MODEL),
        "xattn_w_k": w((L, D_MODEL, XATTN_W), D_MODEL),
        "xattn_w_v": w((L, D_MODEL, XATTN_W), D_MODEL),
        "xattn_q_norm": gain((L, HEAD_DIM)),
        "xattn_k_norm": gain((L, HEAD_DIM)),
        "xattn_w_o": w((L, XATTN_W, D_MODEL), XATTN_W),
        "ffn2_norm": gain((L, D_MODEL)),
        "ffn2_w_gate": w((L, D_MODEL, D_FF), D_MODEL),
        "ffn2_w_up": w((L, D_MODEL, D_FF), D_MODEL),
        "ffn2_w_down": w((L, D_FF, D_MODEL), D_FF),
    }


def reference(x, mem, ffn1_norm, ffn1_w_gate, ffn1_w_up, ffn1_w_down, mix_norm, w_in,
              attn_q_norm, attn_k_norm, gla_w_gate2, gla_b_gate2, gla_out_norm, w_out,
              xattn_norm, mem_norm, xattn_w_q, xattn_w_k, xattn_w_v, xattn_q_norm, xattn_k_norm,
              xattn_w_o, ffn2_norm, ffn2_w_gate, ffn2_w_up, ffn2_w_down):
    S = x.shape[1]
    pos = jnp.arange(S, dtype=jnp.int32)
    for l in range(DEPTH):
        x = x + 0.5 * swiglu(rms_norm(x, ffn1_norm[l]), ffn1_w_gate[l], ffn1_w_up[l], ffn1_w_down[l])
        x = x + hybrid_mixer(rms_norm(x, mix_norm[l]), pos, w_in[l], attn_q_norm[l], attn_k_norm[l],
                             gla_w_gate2[l], gla_b_gate2[l], gla_out_norm[l], w_out[l])
        x = x + cross_attention(rms_norm(x, xattn_norm[l]), rms_norm(mem, mem_norm[l]),
                                xattn_w_q[l], xattn_w_k[l], xattn_w_v[l],
                                xattn_q_norm[l], xattn_k_norm[l], xattn_w_o[l])
        x = x + 0.5 * swiglu(rms_norm(x, ffn2_norm[l]), ffn2_w_gate[l], ffn2_w_up[l], ffn2_w_down[l])
    return x
```

```cpp
#include <hip/hip_runtime.h>
#include <hip/hip_cooperative_groups.h>
#include <cstdio>
#include <cstdint>
namespace cg = cooperative_groups;
__device__ __forceinline__ int tid_now() { int t = threadIdx.x; asm volatile("" : "+v"(t)); return t; }
namespace pg8 {
#define PG8_LAS __attribute__((address_space(3)))
typedef unsigned short bf16_t;
typedef short bf16x8 __attribute__((ext_vector_type(8)));
typedef float f32x4 __attribute__((ext_vector_type(4)));
typedef unsigned u32x4 __attribute__((ext_vector_type(4)));
constexpr int BM = 256, BK = 64, HALF = 128, HTB = HALF * BK * 2  , STAGE_BYTES = 8 * HTB, NXCD = 8, WGM = 8;

__host__ __device__ __forceinline__ int lds_byte(int r, int c) { const int st = (r >> 4) * 2 + (c >> 5), rr = r & 15, cc = c & 31, ob = rr * 64 + cc * 2; return st * 1024 + (ob ^ (((ob >> 9) & 1) << 5)); }
__host__ __device__ __forceinline__ void stage_rc(int b, int& R, int& C) { const int st = b / 1024, sb = b % 1024, swz = sb ^ (((sb >> 9) & 1) << 5); R = (st >> 1) * 16 + swz / 64; C = (st & 1) * 32 + (swz % 64) / 2; }
__host__ __device__ __forceinline__ int perm32(int rho) { const int n = rho >> 4, i = rho & 15; return 8 * (i >> 2) + 4 * n + (i & 3); }

struct Unit { int pm, pn; };
struct Gemm { const bf16_t* A; const bf16_t* Bt; int M, N, K; };

struct StaticOrder {
    int nM, nN, nwg, G, c;
    __host__ __device__ void init(int M, int N, int G_, int c_) { nM = M / BM; nN = N / BM; nwg = nM * nN; G = G_; c = c_; }
    __host__ __device__ bool next(int i, Unit& u) const {
        const long L = (long)i * G + c; if (L >= nwg) return false;
        int wgid = (int)L; { const int q = nwg / NXCD, r = nwg % NXCD, xcd = wgid % NXCD, off = wgid / NXCD; wgid = (xcd < r ? xcd * (q + 1) : r * (q + 1) + (xcd - r) * q) + off; }
        const int nig = WGM * nN, gid = wgid / nig, fm = gid * WGM, gsz = (nM - fm) < WGM ? (nM - fm) : WGM;
        u.pm = fm + ((wgid % nig) % gsz); u.pn = (wgid % nig) / gsz; return true;
    }
    __device__ __forceinline__ void a_ready(const Unit&) const {}
    __device__ __forceinline__ void done(const Unit&) const {}
};

__device__ __forceinline__ unsigned cvt_pk_bf16(float lo, float hi) { unsigned r; asm volatile("v_cvt_pk_bf16_f32 %0, %1, %2" : "=v"(r) : "v"(lo), "v"(hi)); return r; }
__device__ __forceinline__ float row_rs(const float* ssq, int row, int fq) {
    const f32x4 a = *(const f32x4*)(ssq + (size_t)row * 32 + fq * 8), b = *(const f32x4*)(ssq + (size_t)row * 32 + fq * 8 + 4);
    float s = ((a[0] + a[1]) + (a[2] + a[3])) + ((b[0] + b[1]) + (b[2] + b[3]));
    s += __shfl_xor(s, 16); s += __shfl_xor(s, 32);
    return __builtin_amdgcn_rsqf(s * (1.0f / 2048.0f) + 1e-6f);
}
__device__ __forceinline__ float row_ms(const float* ssq, int row, int fq) {
    const f32x4 a = *(const f32x4*)(ssq + (size_t)row * 32 + fq * 8), b = *(const f32x4*)(ssq + (size_t)row * 32 + fq * 8 + 4);
    float s = ((a[0] + a[1]) + (a[2] + a[3])) + ((b[0] + b[1]) + (b[2] + b[3]));
    s += __shfl_xor(s, 16); s += __shfl_xor(s, 32);
    return s * (1.0f / 2048.0f) + 1e-6f;
}
__device__ __forceinline__ float silu_f(float g) { return g * __builtin_amdgcn_rcpf(1.0f + __builtin_amdgcn_exp2f(-1.4426950408889634f * g)); }
struct EpiSwiglu {
    static constexpr bool PERM = true, AFTER_DRAIN = false;
    bf16_t* O; int ldc; const float* ssq;
    __device__ __forceinline__ void operator()(const f32x4 (&acc)[2][2][4][2], const Unit& u, int wr, int wc, int fr, int fq) const {
        const int row0 = u.pm * BM + wr * 64 + fr, col0 = u.pn * HALF + wc * 32 + 8 * fq;
#pragma unroll
        for (int ai = 0; ai < 2; ++ai)
#pragma unroll
            for (int m = 0; m < 4; ++m) { const int row = row0 + ai * HALF + m * 16; const float ms = row_ms(ssq, row, fq);
                const float cexp = -1.4426950408889634f * __builtin_amdgcn_rsqf(ms);
                float v[8];
#pragma unroll
                for (int n = 0; n < 2; ++n)
#pragma unroll
                    for (int i = 0; i < 4; ++i) { const float a = acc[ai][0][m][n][i], b = acc[ai][1][m][n][i];
                        v[n * 4 + i] = (a * b) * __builtin_amdgcn_rcpf(__builtin_fmaf(__builtin_amdgcn_exp2f(a * cexp), ms, ms)); }
                u32x4 w; w.x = cvt_pk_bf16(v[0], v[1]); w.y = cvt_pk_bf16(v[2], v[3]); w.z = cvt_pk_bf16(v[4], v[5]); w.w = cvt_pk_bf16(v[6], v[7]);
                *(u32x4*)(O + (size_t)row * ldc + col0) = w; }
    }
};
struct EpiResid {
    static constexpr bool PERM = true, AFTER_DRAIN = false;
    const float* base32; bf16_t* xb; float* out32; float* ssq_out; float alpha;
    __device__ __forceinline__ void operator()(const f32x4 (&acc)[2][2][4][2], const Unit& u, int wr, int wc, int fr, int fq) const {
        const int row0 = u.pm * BM + wr * 64 + fr, col0 = u.pn * BM + wc * 32 + 8 * fq;
#pragma unroll
        for (int ai = 0; ai < 2; ++ai)
#pragma unroll
            for (int m = 0; m < 4; ++m) { const int row = row0 + ai * HALF + m * 16; float q = 0.f;
#pragma unroll
                for (int bj = 0; bj < 2; ++bj) { const size_t off = (size_t)row * 2048 + col0 + bj * HALF;
                    f32x4 b0, b1;
                    if (base32) { b0 = *(const f32x4*)(base32 + off); b1 = *(const f32x4*)(base32 + off + 4); }
                    else { const u32x4 bw = *(const u32x4*)(xb + off);
                        b0 = (f32x4){__uint_as_float(bw.x << 16), __uint_as_float(bw.x & 0xffff0000u), __uint_as_float(bw.y << 16), __uint_as_float(bw.y & 0xffff0000u)};
                        b1 = (f32x4){__uint_as_float(bw.z << 16), __uint_as_float(bw.z & 0xffff0000u), __uint_as_float(bw.w << 16), __uint_as_float(bw.w & 0xffff0000u)}; }
                    const f32x4 x0 = b0 + acc[ai][bj][m][0] * alpha, x1 = b1 + acc[ai][bj][m][1] * alpha;
                    q += (x0[0] * x0[0] + x0[1] * x0[1]) + (x0[2] * x0[2] + x0[3] * x0[3]) + (x1[0] * x1[0] + x1[1] * x1[1]) + (x1[2] * x1[2] + x1[3] * x1[3]);
                    if (out32) { *(f32x4*)(out32 + off) = x0; *(f32x4*)(out32 + off + 4) = x1; }
                    else { u32x4 w; w.x = cvt_pk_bf16(x0[0], x0[1]); w.y = cvt_pk_bf16(x0[2], x0[3]); w.z = cvt_pk_bf16(x1[0], x1[1]); w.w = cvt_pk_bf16(x1[2], x1[3]);
                        *(u32x4*)(xb + off) = w; } }
                if (ssq_out) { q += __shfl_xor(q, 16); q += __shfl_xor(q, 32); if (fq == 0) ssq_out[(size_t)row * 32 + u.pn * 4 + wc] = q; } }
    }
};
struct EpiScale {
    static constexpr bool PERM = true, AFTER_DRAIN = false;
    bf16_t* O; int ldc; const float* ssq;
    __device__ __forceinline__ void operator()(const f32x4 (&acc)[2][2][4][2], const Unit& u, int wr, int wc, int fr, int fq) const {
        const int row0 = u.pm * BM + wr * 64 + fr, col0 = u.pn * BM + wc * 32 + 8 * fq;
#pragma unroll
        for (int ai = 0; ai < 2; ++ai)
#pragma unroll
            for (int m = 0; m < 4; ++m) { const int row = row0 + ai * HALF + m * 16; const float rs = ssq ? row_rs(ssq, row, fq) : 1.0f;
#pragma unroll
                for (int bj = 0; bj < 2; ++bj) { const f32x4 v0 = acc[ai][bj][m][0] * rs, v1 = acc[ai][bj][m][1] * rs;
                    u32x4 w; w.x = cvt_pk_bf16(v0[0], v0[1]); w.y = cvt_pk_bf16(v0[2], v0[3]); w.z = cvt_pk_bf16(v1[0], v1[1]); w.w = cvt_pk_bf16(v1[2], v1[3]);
                    *(u32x4*)(O + (size_t)row * ldc + col0 + bj * HALF) = w; } }
    }
};
template <class Epi, class Sched, bool ALIGN_EPI = false, bool SP2 = false>
__device__ __forceinline__ void gemm_phase(PG8_LAS unsigned char* lds, const Gemm g, const Sched& S, const Epi& E) {
    const int tid = tid_now(), wid = __builtin_amdgcn_readfirstlane(tid >> 6), lane = tid & 63, wr = wid >> 2, wc = wid & 3, fr = lane & 15, fq = lane >> 4;
    const int K = g.K, nt = K / BK;
    unsigned voffA[2], voffB[2];
#pragma unroll
    for (int i = 0; i < 2; ++i) { int R, C; stage_rc(tid * 16 + i * 8192, R, C); const int Rb = Epi::PERM ? ((R & ~31) + perm32(R & 31)) : R;
        voffA[i] = (unsigned)(R * K + C) * 2u; voffB[i] = (unsigned)(Rb * K + C) * 2u; }
    const size_t kstep = (size_t)(BK * 2);
    const size_t hstep = (size_t)HALF * K * 2;
    const size_t tstep = 2 * hstep;
    const unsigned ldsw = (unsigned)wid * 1024u;
    const int aoff = lds_byte(wr * 64 + fr, fq * 8), boff = lds_byte(wc * 32 + fr, fq * 8);
#define PG8_SA(b, h) (((b) * 2 + (h)) * HTB)
#define PG8_SB(b, h) ((4 + (b) * 2 + (h)) * HTB)
#define PG8_STAGE(bufoff, gbase, voff) do { _Pragma("unroll") for (int _i = 0; _i < 2; ++_i) \
        __builtin_amdgcn_global_load_lds((const unsigned*)((const char*)(gbase) + (voff)[_i]), (PG8_LAS unsigned*)(lds + (bufoff) + ldsw + _i * 8192), 16, 0, 0); } while (0)
#define PG8_LDA(dst, b, h) do { _Pragma("unroll") for (int m = 0; m < 4; ++m) _Pragma("unroll") for (int k = 0; k < 2; ++k) dst[m][k] = *(const PG8_LAS bf16x8*)(lds + PG8_SA(b, h) + aoff + m * 2048 + k * 1024); } while (0)
#define PG8_LDB(dst, b, h) do { _Pragma("unroll") for (int n = 0; n < 2; ++n) _Pragma("unroll") for (int k = 0; k < 2; ++k) dst[n][k] = *(const PG8_LAS bf16x8*)(lds + PG8_SB(b, h) + boff + n * 2048 + k * 1024); } while (0)
#define PG8_MMA(ai, bj, At, Bt) do { __builtin_amdgcn_s_setprio(1); _Pragma("unroll") for (int m = 0; m < 4; ++m) _Pragma("unroll") for (int n = 0; n < 2; ++n) _Pragma("unroll") for (int k = 0; k < 2; ++k) \
        acc[ai][bj][m][n] = __builtin_amdgcn_mfma_f32_16x16x32_bf16(Bt[n][k], At[m][k], acc[ai][bj][m][n], 0, 0, 0); __builtin_amdgcn_s_setprio(0); } while (0)
#define PG8_WAIT_V(n) asm volatile("s_waitcnt vmcnt(" #n ")" ::: "memory")
#define PG8_WAIT_L(n) asm volatile("s_waitcnt lgkmcnt(" #n ")" ::: "memory")
#define PG8_BAR __builtin_amdgcn_s_barrier()
#define PG8_SCHED __builtin_amdgcn_sched_barrier(0)
    Unit cur, nxt; int ui = 0;
    if (!S.next(0, cur)) return;
    f32x4 acc[2][2][4][2];
#pragma unroll
    for (int a = 0; a < 2; ++a)
#pragma unroll
        for (int b = 0; b < 2; ++b)
#pragma unroll
            for (int m = 0; m < 4; ++m)
#pragma unroll
                for (int n = 0; n < 2; ++n) acc[a][b][m][n] = (f32x4){0.f, 0.f, 0.f, 0.f};
    bf16x8 At[4][2], B0[2][2], B1[2][2];
    const char* cA = (const char*)g.A + (size_t)cur.pm * tstep; const char* cB = (const char*)g.Bt + (size_t)cur.pn * tstep;
    S.a_ready(cur);
    if constexpr (SP2) {
        PG8_STAGE(PG8_SB(0, 0), cB, voffB); PG8_STAGE(PG8_SB(0, 1), cB + hstep, voffB); PG8_STAGE(PG8_SA(0, 0), cA, voffA); PG8_STAGE(PG8_SA(0, 1), cA + hstep, voffA);
        if (wr == 1) PG8_BAR;
        PG8_WAIT_V(2); PG8_BAR;
        PG8_STAGE(PG8_SB(1, 0), cB + kstep, voffB); PG8_STAGE(PG8_SA(1, 0), cA + kstep, voffA); PG8_STAGE(PG8_SB(1, 1), cB + hstep + kstep, voffB);
        PG8_WAIT_V(6); PG8_BAR;
    } else {
        PG8_STAGE(PG8_SB(0, 0), cB, voffB); PG8_STAGE(PG8_SA(0, 0), cA, voffA); PG8_STAGE(PG8_SB(0, 1), cB + hstep, voffB); PG8_STAGE(PG8_SA(0, 1), cA + hstep, voffA);
        if (wr == 1) PG8_BAR;
        PG8_WAIT_V(4); PG8_BAR;
        PG8_STAGE(PG8_SB(1, 0), cB + kstep, voffB); PG8_STAGE(PG8_SA(1, 0), cA + kstep, voffA); PG8_STAGE(PG8_SB(1, 1), cB + hstep + kstep, voffB);
        PG8_WAIT_V(6); PG8_BAR;
    }
    for (;;) {
        const bool has_next = S.next(ui + 1, nxt);
        const char* nA = has_next ? (const char*)g.A + (size_t)nxt.pm * tstep : cA; const char* nB = has_next ? (const char*)g.Bt + (size_t)nxt.pn * tstep : cB;
        for (int t = 0; t < nt; t += 2) {
            const bool last = (t == nt - 2);
            const char* a1 = cA + (size_t)(t + 1) * kstep;
            const char* a2 = last ? nA : cA + (size_t)(t + 2) * kstep; const char* b2 = last ? nB : cB + (size_t)(t + 2) * kstep;
            const char* a3 = a2 + kstep; const char* b3 = b2 + kstep;
            if (last && has_next) S.a_ready(nxt);
            if constexpr (SP2) {
            PG8_LDB(B0, 0, 0); PG8_LDB(B1, 0, 1); PG8_SCHED; PG8_LDA(At, 0, 0); PG8_STAGE(PG8_SA(1, 1), a1 + hstep, voffA);
            PG8_WAIT_V(8); PG8_WAIT_L(0); PG8_BAR; PG8_MMA(0, 0, At, B0); PG8_MMA(0, 1, At, B1); PG8_BAR; PG8_SCHED;
            PG8_LDA(At, 0, 1); PG8_STAGE(PG8_SB(0, 0), b2, voffB); PG8_STAGE(PG8_SB(0, 1), b2 + hstep, voffB); PG8_STAGE(PG8_SA(0, 0), a2, voffA);
            PG8_WAIT_V(8); PG8_WAIT_L(0); PG8_BAR; PG8_MMA(1, 0, At, B0); PG8_MMA(1, 1, At, B1); PG8_BAR; PG8_SCHED;
            PG8_LDB(B0, 1, 0); PG8_LDB(B1, 1, 1); PG8_SCHED; PG8_LDA(At, 1, 0); PG8_STAGE(PG8_SA(0, 1), a2 + hstep, voffA);
            PG8_WAIT_V(8); PG8_WAIT_L(0); PG8_BAR; PG8_MMA(0, 0, At, B0); PG8_MMA(0, 1, At, B1); PG8_BAR; PG8_SCHED;
            PG8_LDA(At, 1, 1); PG8_STAGE(PG8_SB(1, 0), b3, voffB); PG8_STAGE(PG8_SB(1, 1), b3 + hstep, voffB); PG8_STAGE(PG8_SA(1, 0), a3, voffA);
            PG8_WAIT_V(8); PG8_WAIT_L(0); PG8_BAR; PG8_MMA(1, 0, At, B0); PG8_MMA(1, 1, At, B1); PG8_BAR; PG8_SCHED;
            } else {
            PG8_LDB(B0, 0, 0); PG8_SCHED; PG8_LDA(At, 0, 0); PG8_STAGE(PG8_SA(1, 1), a1 + hstep, voffA);
            PG8_WAIT_L(8); PG8_BAR; PG8_WAIT_L(0); PG8_MMA(0, 0, At, B0); PG8_BAR; PG8_SCHED;
            PG8_LDB(B1, 0, 1); PG8_STAGE(PG8_SB(0, 0), b2, voffB);
            PG8_BAR; PG8_WAIT_L(0); PG8_MMA(0, 1, At, B1); PG8_BAR;
            PG8_LDA(At, 0, 1); PG8_STAGE(PG8_SA(0, 0), a2, voffA);
            PG8_BAR; PG8_WAIT_L(0); PG8_MMA(1, 0, At, B0); PG8_BAR; PG8_SCHED;
            PG8_STAGE(PG8_SB(0, 1), b2 + hstep, voffB);
            PG8_WAIT_V(6); PG8_BAR; PG8_MMA(1, 1, At, B1); PG8_BAR;
            PG8_LDB(B0, 1, 0); PG8_SCHED; PG8_LDA(At, 1, 0); PG8_STAGE(PG8_SA(0, 1), a2 + hstep, voffA);
            PG8_WAIT_L(8); PG8_BAR; PG8_WAIT_L(0); PG8_MMA(0, 0, At, B0); PG8_BAR; PG8_SCHED;
            PG8_LDB(B1, 1, 1); PG8_STAGE(PG8_SB(1, 0), b3, voffB);
            PG8_BAR; PG8_WAIT_L(0); PG8_MMA(0, 1, At, B1); PG8_BAR;
            PG8_LDA(At, 1, 1); PG8_STAGE(PG8_SA(1, 0), a3, voffA);
            PG8_BAR; PG8_WAIT_L(0); PG8_MMA(1, 0, At, B0); PG8_BAR; PG8_SCHED;
            PG8_STAGE(PG8_SB(1, 1), b3 + hstep, voffB);
            PG8_WAIT_V(6); PG8_BAR; PG8_MMA(1, 1, At, B1); PG8_BAR;
            }
        }
        if constexpr (ALIGN_EPI) { if (wr == 0) PG8_BAR; }
        if constexpr (!Epi::AFTER_DRAIN) { E(acc, cur, wr, wc, fr, fq); S.done(cur); }
        if (!has_next) break;
#pragma unroll
        for (int a = 0; a < 2; ++a)
#pragma unroll
            for (int b = 0; b < 2; ++b)
#pragma unroll
                for (int m = 0; m < 4; ++m)
#pragma unroll
                    for (int n = 0; n < 2; ++n) acc[a][b][m][n] = (f32x4){0.f, 0.f, 0.f, 0.f};
        cur = nxt; cA = nA; cB = nB; ++ui;
        if constexpr (ALIGN_EPI) { if (wr == 1) PG8_BAR; }
    }
    PG8_WAIT_V(0);
    if constexpr (!ALIGN_EPI) { if (wr == 0) PG8_BAR; }
    PG8_BAR;
    if constexpr (Epi::AFTER_DRAIN) { E.fused(acc, cur, wr, wc, fr, fq, lds, wid, lane); S.done(cur); }
#undef PG8_SA
#undef PG8_SB
#undef PG8_STAGE
#undef PG8_LDA
#undef PG8_LDB
#undef PG8_MMA
#undef PG8_WAIT_V
#undef PG8_WAIT_L
#undef PG8_BAR
#undef PG8_SCHED
}
}

constexpr int TOK = 8192, DM = 2048, SEQ = 2048, DFF = 5632, PROJW = 6144, MIXC = 6160, NMEM = 256;
constexpr float EPS = 1e-6f, LOG2E = 1.4426950408889634f;
constexpr float QSCALE = 0.08838834764831845f * LOG2E;
constexpr size_t MiB = 1u << 20;
constexpr size_t WS_WGU1 = 0, WS_WD1 = 44 * MiB, WS_WIN = 66 * MiB, WS_WOUT = 91 * MiB, WS_WQ = 99 * MiB, WS_WKV = 101 * MiB, WS_WO = 105 * MiB,
                 WS_WGU2 = 107 * MiB, WS_WD2 = 151 * MiB, WS_R1 = 173 * MiB  , WS_H = 269 * MiB  ,
                 WS_MIX = 301 * MiB, WS_DST = 333 * MiB, WS_MEMN = 365 * MiB, WS_KVX = 369 * MiB, WS_QX = 371 * MiB, WS_OX = 379 * MiB,
                 WS_SSQ = 387 * MiB, WS_GLR = 388 * MiB, WS_DECAY = 389 * MiB, WS_ROPE = 390 * MiB, WS_CTL = 392 * MiB  , WS_END = 393 * MiB;
constexpr size_t CTL_ZERO_BYTES = 16384;
constexpr int LDS_BYTES = 147456;
constexpr int NPHASE = 14;

#define LAS __attribute__((address_space(3)))
typedef unsigned short bf16;
typedef unsigned u32x4 __attribute__((ext_vector_type(4)));
typedef unsigned u32x2 __attribute__((ext_vector_type(2)));
typedef float f32x4 __attribute__((ext_vector_type(4)));
typedef short bf16x8 __attribute__((ext_vector_type(8)));
typedef short bf16x4 __attribute__((ext_vector_type(4)));
#define LDS_WAIT() asm volatile("s_waitcnt lgkmcnt(0)" ::: "memory")
__device__ __forceinline__ float bf2f(unsigned short h) { return __uint_as_float((unsigned)h << 16); }
__device__ __forceinline__ float bflo(unsigned w) { return __uint_as_float(w << 16); }
__device__ __forceinline__ float bfhi(unsigned w) { return __uint_as_float(w & 0xffff0000u); }
__device__ __forceinline__ unsigned pk2(float lo, float hi) { return pg8::cvt_pk_bf16(lo, hi); }
__device__ __forceinline__ unsigned short f2bf(float f) { return (unsigned short)(pg8::cvt_pk_bf16(f, 0.f) & 0xffffu); }
__device__ __forceinline__ float wave_sum(float v) {
#pragma unroll
    for (int o = 1; o < 64; o <<= 1) v += __shfl_xor(v, o);
    return v;
}
#define MMA16(X, Y, ACC) ACC = __builtin_amdgcn_mfma_f32_16x16x32_bf16((X), (Y), (ACC), 0, 0, 0)

__device__ __forceinline__ void* ldptr(LAS const unsigned long long* tab, int i) { const unsigned long long v = tab[i];
    const unsigned lo = __builtin_amdgcn_readfirstlane((unsigned)v), hi = __builtin_amdgcn_readfirstlane((unsigned)(v >> 32));
    return (void*)(__attribute__((address_space(1))) void*)(((unsigned long long)hi << 32) | lo); }
#define XB_TMO      128
#define XB_XCNT(j)  (256  + 64 * (j))
#define XB_XSUB(j)  (1280 + 64 * (j))
#define XB_XGEN(j)  (2304 + 64 * (j))
#define XB_TOP      3328
#define XB_TOPGEN   3392
#define XCD_BAR_WORDS 3456
#define XB_SPIN_CAP (1u << 18)

__device__ __forceinline__ unsigned xb_ld(unsigned* p)              { return __hip_atomic_load(p, __ATOMIC_RELAXED, __HIP_MEMORY_SCOPE_AGENT); }
__device__ __forceinline__ unsigned xb_add(unsigned* p, unsigned v) { return __hip_atomic_fetch_add(p, v, __ATOMIC_RELAXED, __HIP_MEMORY_SCOPE_AGENT); }
__device__ __forceinline__ unsigned xb_xcc_id() { return (unsigned)__builtin_amdgcn_s_getreg((3 << 11) | 20) & 0xFu; }
#define XB_SPIN(cond, bar) do { unsigned _sp = 0; while (cond) { __builtin_amdgcn_s_sleep(1); \
    if ((++_sp & 255u) == 0u) { if (xb_ld(&(bar)[XB_TMO])) break; if (_sp > XB_SPIN_CAP) { atomicAdd(&(bar)[XB_TMO], 1u); break; } } } } while (0)

struct XcdBarrier {
    unsigned* bar; unsigned x;
    volatile LAS unsigned* st;
};

__device__ __forceinline__ XcdBarrier xcd_barrier_post(unsigned* bar, volatile LAS unsigned* st) {
    XcdBarrier b; b.bar = bar; b.x = xb_xcc_id(); b.st = st;
    if (threadIdx.x == 0) (void)xb_add(&bar[XB_XCNT(b.x)], 1u);
    return b;
}
__device__ __forceinline__ void xcd_barrier_complete(unsigned* bar, unsigned x, unsigned& nloc, unsigned& nx) {
    const unsigned G = gridDim.x * gridDim.y * gridDim.z;
    unsigned sum, cnt, mine, sp = 0u;
    for (;;) {
        sum = 0u; cnt = 0u; mine = 0u;
#pragma unroll
        for (unsigned j = 0; j < 16; ++j) { const unsigned c = xb_ld(&bar[XB_XCNT(j)]); sum += c; cnt += (c > 0u) ? 1u : 0u; mine = (j == x) ? c : mine; }
        if (sum == G) break;
        __builtin_amdgcn_s_sleep(1);
        if ((++sp & 255u) == 0u) { if (xb_ld(&bar[XB_TMO])) break; if (sp > XB_SPIN_CAP) { atomicAdd(&bar[XB_TMO], 1u); break; } }
    }
    nloc = mine > 0u ? mine : 1u; nx = cnt > 0u ? cnt : 1u;
}

__device__ __forceinline__ void xcd_barrier(const XcdBarrier& b) {
    asm volatile("s_waitcnt vmcnt(0)" ::: "memory");
    __syncthreads();
    if (threadIdx.x == 0) {
        unsigned* bar = b.bar;
        __builtin_amdgcn_s_waitcnt(0);
        unsigned nloc = b.st[0], nx = b.st[1];
        if (nloc == 0u) { xcd_barrier_complete(bar, b.x, nloc, nx); b.st[0] = nloc; b.st[1] = nx; }
        const unsigned old = xb_add(&bar[XB_XSUB(b.x)], 1u);
        const unsigned gen = old / nloc;
        if (old + 1u == (gen + 1u) * nloc) {
            __builtin_amdgcn_fence(__ATOMIC_RELEASE, "agent");
            asm volatile("s_waitcnt vmcnt(0)" ::: "memory");
            const unsigned og = xb_add(&bar[XB_TOP], 1u);
            const unsigned tg = og / nx;
            if (og + 1u == (tg + 1u) * nx) xb_add(&bar[XB_TOPGEN], 1u);
            else XB_SPIN(xb_ld(&bar[XB_TOPGEN]) == tg, bar);
            __builtin_amdgcn_fence(__ATOMIC_ACQUIRE, "agent");
            xb_add(&bar[XB_XGEN(b.x)], 1u);
            asm volatile("s_waitcnt vmcnt(0)" ::: "memory");
        } else {
            XB_SPIN(xb_ld(&bar[XB_XGEN(b.x)]) == gen, bar);
            __builtin_amdgcn_fence(__ATOMIC_ACQUIRE, "agent");
            asm volatile("s_waitcnt vmcnt(0)" ::: "memory");
        }
    }
    __syncthreads();
}

struct Args { const float* in[26]; float* out; unsigned char* ws; int ph_lo, ph_hi; };

__device__ __forceinline__ void p0_tr(const float* __restrict__ W, int K, int N, bf16* WT, int rstride, int roff, LAS float* scr, int item, int lane, const float* gk = nullptr) {
    const int nblk = (N + 63) / 64, kb = item / nblk, nb = item % nblk, k0 = 64 * kb, n0 = 64 * nb;
    const int kq = lane >> 4, n4 = (lane & 15) * 4;
    const bool ok = (n0 + n4) < N;
    f32x4 v[16];
#pragma unroll
    for (int i = 0; i < 16; ++i) v[i] = ok ? __builtin_nontemporal_load((const f32x4*)(W + (size_t)(k0 + 4 * i + kq) * N + n0 + n4)) : (f32x4){0.f, 0.f, 0.f, 0.f};
#pragma unroll
    for (int i = 0; i < 16; ++i)
#pragma unroll
        for (int e = 0; e < 4; ++e) scr[(4 * i + kq) * 69 + n4 + e] = v[i][e];
    LDS_WAIT(); asm volatile("" ::: "memory");
    const int c = lane & 7;
    f32x4 ga = {1.f, 1.f, 1.f, 1.f}, gb = {1.f, 1.f, 1.f, 1.f};
    if (gk) { ga = *(const f32x4*)(gk + k0 + 8 * c); gb = *(const f32x4*)(gk + k0 + 8 * c + 4); }
#pragma unroll
    for (int j = 0; j < 8; ++j) { const int n = (lane >> 3) + 8 * j, gn = n0 + n; const LAS float* sp = scr + (8 * c) * 69 + n;
        u32x4 o; o.x = pk2(sp[0 * 69] * ga[0], sp[1 * 69] * ga[1]); o.y = pk2(sp[2 * 69] * ga[2], sp[3 * 69] * ga[3]); o.z = pk2(sp[4 * 69] * gb[0], sp[5 * 69] * gb[1]); o.w = pk2(sp[6 * 69] * gb[2], sp[7 * 69] * gb[3]);
        if (gn < N) { const int dr = (gn >> 7) * rstride + roff + (gn & 127); *(u32x4*)(WT + (size_t)dr * K + k0 + 8 * c) = o; } }
    LDS_WAIT(); asm volatile("" ::: "memory");
}

constexpr int QP = 144, VP = 72;
constexpr int VPA = 80;
constexpr int AT_QS = 0, AT_KS = 128 * QP * 2, AT_VT = AT_KS + 2 * 64 * QP * 2, AT_NB3 = 64 * QP * 2 + 128 * VPA * 2  , AT_BT = 3 * AT_NB3, AT_END = AT_BT + 2176 * 4;
__device__ __forceinline__ int vperm(int key) { return (key & 32) + 8 * ((key & 15) >> 2) + 4 * ((key >> 4) & 1) + (key & 3); }
struct KVRegs { u32x4 ka, kb, va, vb; };
__device__ __forceinline__ void attn_build_bias(LAS unsigned char* lds, int tid, float bref) {
    LAS float* BT = (LAS float*)(lds + AT_BT);
    for (int j = tid; j < 2176; j += 512) { const int d = 2047 - j;
        int c = ((d & 15) == 0) ? 1 : 0; c += (((d & 3) == 0) && d <= 512) ? 1 : 0; c += (d <= 128) ? 1 : 0;
        BT[j] = (d < 0 || c == 0) ? -INFINITY : ((c == 1) ? 0.f : ((c == 2) ? 1.f : 1.5849625007211562f)) - bref; }
}
__device__ __forceinline__ float attn_logit_bound(const float* gq, const float* gk, int lane, float extra) {
    float a = fmaxf(fabsf(gq[lane]), fabsf(gq[lane + 64])), b = fmaxf(fabsf(gk[lane]), fabsf(gk[lane + 64]));
#pragma unroll
    for (int o = 1; o < 64; o <<= 1) { a = fmaxf(a, __shfl_xor(a, o)); b = fmaxf(b, __shfl_xor(b, o)); }
    return fminf(128.0f * a * b * QSCALE * 1.02f + 0.5f + extra, 60.0f);
}
template <int MODE>
__device__ __forceinline__ void attn_item(LAS unsigned char* lds, const bf16* Qp, int ldq, const bf16* Kp, const bf16* Vp, int ldkv, int ntiles  , int q0,
                                          bf16* Op, int ldo, const float* qg, const float* kg, const bf16* Bq = nullptr, const float* ssq = nullptr, int grow0 = 0, float bref = 0.f) {
    const int tid = tid_now(), lane = tid & 63, w = tid >> 6, fr = lane & 15, fq = lane >> 4;
    LAS bf16* Qs = (LAS bf16*)(lds + (MODE == 0 ? 2 * AT_NB3 : AT_QS)); const LAS float* BT = (const LAS float*)(lds + AT_BT);
    auto koff = [&](int b) { return MODE == 0 ? b * AT_NB3 : AT_KS + b * (64 * QP * 2); };
    auto voff = [&](int b) { return MODE == 0 ? b * AT_NB3 + 64 * QP * 2 : AT_VT + b * (128 * VPA * 2); };
    const int kr = tid >> 3, kj = tid & 7;
    const int vr = tid & 63, vj = tid >> 6;
    auto norm16 = [&](u32x4& a, u32x4& b, const float* gn, float extra) {
        float x[16];
#pragma unroll
        for (int e = 0; e < 4; ++e) { x[2 * e] = bflo(a[e]); x[2 * e + 1] = bfhi(a[e]); x[8 + 2 * e] = bflo(b[e]); x[9 + 2 * e] = bfhi(b[e]); }
        float sq = 0.f;
#pragma unroll
        for (int e = 0; e < 16; ++e) sq += x[e] * x[e];
        sq += __shfl_xor(sq, 1); sq += __shfl_xor(sq, 2); sq += __shfl_xor(sq, 4);
        const float rs = __builtin_amdgcn_rsqf(sq * (1.f / 128.f) + EPS) * extra;
        const f32x4 g0 = *(const f32x4*)(gn + 8 * kj), g1 = *(const f32x4*)(gn + 8 * kj + 4), g2 = *(const f32x4*)(gn + 64 + 8 * kj), g3 = *(const f32x4*)(gn + 64 + 8 * kj + 4);
        a[0] = pk2(x[0] * rs * g0[0], x[1] * rs * g0[1]); a[1] = pk2(x[2] * rs * g0[2], x[3] * rs * g0[3]); a[2] = pk2(x[4] * rs * g1[0], x[5] * rs * g1[1]); a[3] = pk2(x[6] * rs * g1[2], x[7] * rs * g1[3]);
        b[0] = pk2(x[8] * rs * g2[0], x[9] * rs * g2[1]); b[1] = pk2(x[10] * rs * g2[2], x[11] * rs * g2[3]); b[2] = pk2(x[12] * rs * g3[0], x[13] * rs * g3[1]); b[3] = pk2(x[14] * rs * g3[2], x[15] * rs * g3[3]);
    };
    auto load_tile = [&](KVRegs& r, int t) {
        const bf16* ks = Kp + (size_t)(t * 64 + kr) * ldkv; r.ka = *(const u32x4*)(ks + 8 * kj); r.kb = *(const u32x4*)(ks + 64 + 8 * kj);
        if (MODE == 0) { const bf16* vs = Vp + (size_t)(tid >> 2) * SEQ + t * 64 + 16 * (tid & 3); r.va = *(const u32x4*)vs; r.vb = *(const u32x4*)(vs + 8); }
        else { const bf16* vs = Vp + (size_t)(t * 64 + vr) * ldkv; r.va = *(const u32x4*)(vs + 8 * vj); r.vb = *(const u32x4*)(vs + 64 + 8 * vj); } };
    auto stage = [&](KVRegs& r, int buf) {
        LAS bf16* Ks = (LAS bf16*)(lds + koff(buf)); LAS bf16* VT = (LAS bf16*)(lds + voff(buf));
        if (MODE >= 1) norm16(r.ka, r.kb, kg, 1.0f);
        *(LAS u32x4*)(Ks + kr * QP + 8 * kj) = r.ka; *(LAS u32x4*)(Ks + kr * QP + 64 + 8 * kj) = r.kb;
        if (MODE == 0) { *(LAS u32x4*)(VT + (tid >> 2) * VPA + 16 * (tid & 3)) = r.va; *(LAS u32x4*)(VT + (tid >> 2) * VPA + 16 * (tid & 3) + 8) = r.vb; }
        else
#pragma unroll
        for (int e = 0; e < 4; ++e) { const int pv = vperm(vr);
                                      VT[(8 * vj + 2 * e) * VPA + pv] = (bf16)(r.va[e] & 0xffffu); VT[(8 * vj + 2 * e + 1) * VPA + pv] = (bf16)(r.va[e] >> 16);
                                      VT[(64 + 8 * vj + 2 * e) * VPA + pv] = (bf16)(r.vb[e] & 0xffffu); VT[(64 + 8 * vj + 2 * e + 1) * VPA + pv] = (bf16)(r.vb[e] >> 16); } };
    KVRegs r0, r1;
    load_tile(r0, 0); load_tile(r1, 1);
    if (MODE == 2) {
        constexpr int GP = 80, GBUF = 128 * GP * 2;
        const int lr = tid >> 2, lc = (tid & 3) * 16;
        const bf16* ap = Qp + (size_t)lr * ldq + lc; const bf16* bp = Bq + (size_t)lr * 2048 + lc;
        u32x4 ra[4][4];
#define QG_LD(j, step) do { const int ko_ = (step) * 64; ra[j][0] = *(const u32x4*)(ap + ko_); ra[j][1] = *(const u32x4*)(ap + ko_ + 8); ra[j][2] = *(const u32x4*)(bp + ko_); ra[j][3] = *(const u32x4*)(bp + ko_ + 8); } while (0)
#define QG_ST(j, buf) do { LAS bf16* As_ = (LAS bf16*)(lds + AT_KS + (buf) * 2 * GBUF); LAS bf16* Bs_ = As_ + 128 * GP; \
        *(LAS u32x4*)(As_ + lr * GP + lc) = ra[j][0]; *(LAS u32x4*)(As_ + lr * GP + lc + 8) = ra[j][1]; *(LAS u32x4*)(Bs_ + lr * GP + lc) = ra[j][2]; *(LAS u32x4*)(Bs_ + lr * GP + lc + 8) = ra[j][3]; } while (0)
        QG_LD(0, 0); QG_LD(1, 1); QG_LD(2, 2); QG_LD(3, 3);
        QG_ST(0, 0); QG_LD(0, 4);
        __syncthreads();
        f32x4 acc[8];
#pragma unroll
        for (int i = 0; i < 8; ++i) acc[i] = (f32x4){0.f, 0.f, 0.f, 0.f};
#pragma unroll 1
        for (int st4 = 0; st4 < 32; st4 += 4) {
#pragma unroll
            for (int u = 0; u < 4; ++u) { const int st = st4 + u, cb = u & 1, j = (u + 1) & 3;
                if (st + 1 < 32) QG_ST(j, cb ^ 1);
                if (st + 5 < 32) QG_LD(j, st + 5);
                const LAS bf16* As = (const LAS bf16*)(lds + AT_KS + cb * 2 * GBUF); const LAS bf16* Bs = As + 128 * GP;
                bf16x8 af[2], bfr[8][2];
#pragma unroll
                for (int ks = 0; ks < 2; ++ks) af[ks] = *(const LAS bf16x8*)(As + (16 * w + fr) * GP + 32 * ks + 8 * fq);
#pragma unroll
                for (int nb = 0; nb < 8; ++nb)
#pragma unroll
                    for (int ks = 0; ks < 2; ++ks) bfr[nb][ks] = *(const LAS bf16x8*)(Bs + (16 * nb + fr) * GP + 32 * ks + 8 * fq);
                __builtin_amdgcn_sched_barrier(0);
#pragma unroll
                for (int ks = 0; ks < 2; ++ks)
#pragma unroll
                    for (int nb = 0; nb < 8; ++nb) MMA16(bfr[nb][ks], af[ks], acc[nb]);
                __builtin_amdgcn_sched_barrier(0);
                __syncthreads(); }
        }
#undef QG_LD
#undef QG_ST
        const float rs = pg8::row_rs(ssq, grow0 + 16 * w + fr, fq);
        float sq = 0.f;
#pragma unroll
        for (int nb = 0; nb < 8; ++nb) { acc[nb] = acc[nb] * rs; sq += (acc[nb][0] * acc[nb][0] + acc[nb][1] * acc[nb][1]) + (acc[nb][2] * acc[nb][2] + acc[nb][3] * acc[nb][3]); }
        sq += __shfl_xor(sq, 16); sq += __shfl_xor(sq, 32);
        const float rn = __builtin_amdgcn_rsqf(sq * (1.f / 128.f) + EPS) * QSCALE;
#pragma unroll
        for (int nb = 0; nb < 8; ++nb) { const f32x4 gv = *(const f32x4*)(qg + 16 * nb + 4 * fq);
            u32x2 ov; ov.x = pk2(acc[nb][0] * rn * gv[0], acc[nb][1] * rn * gv[1]); ov.y = pk2(acc[nb][2] * rn * gv[2], acc[nb][3] * rn * gv[3]);
            *(LAS u32x2*)(Qs + (16 * w + fr) * QP + 16 * nb + 4 * fq) = ov; }
        __syncthreads();
    } else {
#pragma unroll
    for (int p = 0; p < 2; ++p) {
        const bf16* src = Qp + (size_t)(p * 64 + kr) * ldq;
        u32x4 a = *(const u32x4*)(src + 8 * kj), b = *(const u32x4*)(src + 64 + 8 * kj);
        if (MODE == 1) norm16(a, b, qg, QSCALE);
        *(LAS u32x4*)(Qs + (p * 64 + kr) * QP + 8 * kj) = a; *(LAS u32x4*)(Qs + (p * 64 + kr) * QP + 64 + 8 * kj) = b;
    }
    }
    stage(r0, 0); if (2 < ntiles) load_tile(r0, 2);
    if (MODE == 0) { stage(r1, 1); if (3 < ntiles) load_tile(r1, 3); }
    __syncthreads();
    const int rp = w >> 1, kh = w & 1;
    bf16x8 qf[2][4];
#pragma unroll
    for (int rb = 0; rb < 2; ++rb)
#pragma unroll
        for (int ks = 0; ks < 4; ++ks) qf[rb][ks] = *(const LAS bf16x8*)(Qs + (32 * rp + 16 * rb + fr) * QP + 32 * ks + 8 * fq);
    f32x4 o[2][8];
#pragma unroll
    for (int rb = 0; rb < 2; ++rb)
#pragma unroll
        for (int i = 0; i < 8; ++i) o[rb][i] = (f32x4){0.f, 0.f, 0.f, 0.f};
    float lrun[2] = {0.f, 0.f};
    auto compute = [&](int buf, int t) {
        const LAS bf16* Ks = (const LAS bf16*)(lds + koff(buf)); const LAS bf16* VT = (const LAS bf16*)(lds + voff(buf));
        bf16x8 kf[2][4]; float bias[2][2][4];
#pragma unroll
        for (int kb = 0; kb < 2; ++kb)
#pragma unroll
            for (int ks = 0; ks < 4; ++ks) kf[kb][ks] = *(const LAS bf16x8*)(Ks + (32 * kh + 16 * kb + fr) * QP + 32 * ks + 8 * fq);
        if (MODE == 0) { const LAS float* bp = BT + (2047 - 16 - (q0 + 32 * rp + fr - t * 64 - 32 * kh - 4 * fq));
#pragma unroll
                for (int kb = 0; kb < 2; ++kb)
#pragma unroll
                    for (int i = 0; i < 4; ++i) bias[0][kb][i] = bp[16 * (kb + 1) + i]; }
        __builtin_amdgcn_sched_barrier(0);
        f32x4 s[2][2];
#pragma unroll
        for (int rb = 0; rb < 2; ++rb)
#pragma unroll
            for (int kb = 0; kb < 2; ++kb) s[rb][kb] = (f32x4){0.f, 0.f, 0.f, 0.f};
        bf16x8 pf[2];
        auto smax = [&](int rb) {
            if (MODE == 0) { s[rb][0] = s[rb][0] + (f32x4){bias[rb][0][0], bias[rb][0][1], bias[rb][0][2], bias[rb][0][3]}; s[rb][1] = s[rb][1] + (f32x4){bias[rb][1][0], bias[rb][1][1], bias[rb][1][2], bias[rb][1][3]}; }
            else { s[rb][0] = s[rb][0] - bref; s[rb][1] = s[rb][1] - bref; }
            float ps = 0.f;
#pragma unroll
            for (int kb = 0; kb < 2; ++kb)
#pragma unroll
                for (int i = 0; i < 4; ++i) { s[rb][kb][i] = __builtin_amdgcn_exp2f(s[rb][kb][i]); ps += s[rb][kb][i]; }
            lrun[rb] += ps;
            u32x4 pw; pw.x = pk2(s[rb][0][0], s[rb][0][1]); pw.y = pk2(s[rb][0][2], s[rb][0][3]); pw.z = pk2(s[rb][1][0], s[rb][1][1]); pw.w = pk2(s[rb][1][2], s[rb][1][3]);
            pf[rb] = __builtin_bit_cast(bf16x8, pw); };
#pragma unroll
        for (int ks = 0; ks < 4; ++ks)
#pragma unroll
            for (int kb = 0; kb < 2; ++kb) MMA16(kf[kb][ks], qf[0][ks], s[0][kb]);
        __builtin_amdgcn_sched_barrier(0);
        bf16x8 vf[8];
#pragma unroll
        for (int db = 0; db < 8; ++db) vf[db] = *(const LAS bf16x8*)(VT + (16 * db + fr) * VPA + 32 * kh + 8 * fq);
        if (MODE == 0) { const LAS float* bp = BT + (2047 - 16 - (q0 + 32 * rp + fr - t * 64 - 32 * kh - 4 * fq));
#pragma unroll
            for (int kb = 0; kb < 2; ++kb)
#pragma unroll
                for (int i = 0; i < 4; ++i) bias[1][kb][i] = bp[16 * kb + i]; }
#pragma unroll
        for (int ks = 0; ks < 4; ++ks)
#pragma unroll
            for (int kb = 0; kb < 2; ++kb) MMA16(kf[kb][ks], qf[1][ks], s[1][kb]);
        smax(0);
#pragma unroll
        for (int g = 0; g < 8; ++g) { __builtin_amdgcn_sched_group_barrier(0x008, 1, 0); __builtin_amdgcn_sched_group_barrier(0x100, 1, 0); __builtin_amdgcn_sched_group_barrier(0x002, 4, 0); }
        __builtin_amdgcn_sched_barrier(0);
#pragma unroll
        for (int db = 0; db < 8; ++db) MMA16(vf[db], pf[0], o[0][db]);
        smax(1);
#pragma unroll
        for (int g = 0; g < 8; ++g) { __builtin_amdgcn_sched_group_barrier(0x008, 1, 1); __builtin_amdgcn_sched_group_barrier(0x002, 4, 1); }
        __builtin_amdgcn_sched_barrier(0);
#pragma unroll
        for (int db = 0; db < 8; ++db) MMA16(vf[db], pf[1], o[1][db]);
        __builtin_amdgcn_sched_barrier(0);
    };
    if (MODE == 0) {
        __syncthreads();
        int cur = 0;
        for (int t = 0; t < ntiles; t += 2) {
            int b2 = cur + 2; if (b2 >= 3) b2 -= 3;
            if (t + 2 < ntiles) { stage(r0, b2); if (t + 4 < ntiles) load_tile(r0, t + 4); }
            compute(cur, t);
            __syncthreads();
            int b1 = cur + 1; if (b1 >= 3) b1 -= 3;
            if (t + 3 < ntiles) { stage(r1, cur); if (t + 5 < ntiles) load_tile(r1, t + 5); }
            compute(b1, t + 1);
            __syncthreads();
            cur = b2;
        }
    } else {
    for (int t = 0; t < ntiles; t += 2) {
        stage(r1, 1); if (t + 3 < ntiles) load_tile(r1, t + 3);
        compute(0, t);
        __syncthreads();
        if (t + 2 < ntiles) { stage(r0, 0); if (t + 4 < ntiles) load_tile(r0, t + 4); }
        compute(1, t + 1);
        __syncthreads();
    }
    }
    LAS float* X = (LAS float*)(lds + (MODE == 0 ? 0 : AT_KS));
    if (kh == 1) {
#pragma unroll
        for (int rb = 0; rb < 2; ++rb) {
#pragma unroll
            for (int db = 0; db < 8; ++db)
#pragma unroll
                for (int i = 0; i < 4; ++i) X[(rp * 68 + rb * 32 + db * 4 + i) * 64 + lane] = o[rb][db][i];
            X[(rp * 68 + 66 + rb) * 64 + lane] = lrun[rb]; }
    }
    __syncthreads();
    if (kh == 0) {
#pragma unroll
        for (int rb = 0; rb < 2; ++rb) {
            float l = lrun[rb] + X[(rp * 68 + 66 + rb) * 64 + lane]; l += __shfl_xor(l, 16); l += __shfl_xor(l, 32);
            const float inv = 1.0f / l;
            bf16* orow = Op + (size_t)(32 * rp + 16 * rb + fr) * ldo + 4 * fq;
#pragma unroll
            for (int db = 0; db < 8; ++db) { float v[4];
#pragma unroll
                for (int i = 0; i < 4; ++i) v[i] = (o[rb][db][i] + X[(rp * 68 + rb * 32 + db * 4 + i) * 64 + lane]) * inv;
                u32x2 ov; ov.x = pk2(v[0], v[1]); ov.y = pk2(v[2], v[3]); *(u32x2*)(orow + 16 * db) = ov; }
        }
    }
    __syncthreads();
}

__device__ __forceinline__ void gla_logdecay(float (&b)[16], float& blast, const LAS float* glrs, const float (&wcol)[16], const float bias, int d, int g, LAS float* tot) {
    float run = 0.f;
#pragma unroll
    for (int ii = 0; ii < 16; ++ii) { const LAS f32x4* gr = (const LAS f32x4*)(glrs + (16 * g + ii) * 16); float z = bias;
#pragma unroll
        for (int r4 = 0; r4 < 4; ++r4) { const f32x4 gv = gr[r4]; z += gv[0] * wcol[4 * r4] + gv[1] * wcol[4 * r4 + 1] + gv[2] * wcol[4 * r4 + 2] + gv[3] * wcol[4 * r4 + 3]; }
        const float la = -(fmaxf(-z, 0.f) + __logf(1.0f + __expf(-fabsf(z)))) * (1.0f / 16.0f);
        run += la; b[ii] = run; }
    tot[g * 128 + d] = run;
    __syncthreads();
    float off = 0.f, all = 0.f;
#pragma unroll
    for (int gg = 0; gg < 4; ++gg) { const float tv = tot[gg * 128 + d]; all += tv; if (gg < g) off += tv; }
#pragma unroll
    for (int ii = 0; ii < 16; ++ii) b[ii] += off;
    blast = all;
}
constexpr int GL_QE = 0, GL_KE = 64 * QP * 2, GL_VT = GL_KE + 64 * QP * 2, GL_AS = GL_VT + 256 * VP * 2, GL_TOT = GL_AS + 64 * VP * 2, GL_RED = GL_TOT + 2048, GL_GLR = GL_RED + 2048, GL_END = GL_GLR + 4096;
constexpr int GA_KDT = 0, GA_KRAW = 128 * VP * 2, GA_VT = GA_KRAW + 64 * QP * 2, GA_TOT = GA_VT + 256 * VP * 2, GA_GLR = GA_TOT + 2048, GA_END = GA_GLR + 4096;
__device__ __forceinline__ void gla_stage_glr(LAS float* glrs, const float* glr, int R0, int tid) { if (tid < 256) *(LAS f32x4*)(glrs + tid * 4) = *(const f32x4*)(glr + (size_t)R0 * 16 + tid * 4); }
__device__ __forceinline__ void gla_stage_raw(LAS bf16* dst, const bf16* src, int ld, int tid) { const int r = tid >> 3, j = tid & 7; const bf16* p = src + (size_t)r * ld;
    *(LAS u32x4*)(dst + r * QP + 8 * j) = *(const u32x4*)(p + 8 * j); *(LAS u32x4*)(dst + r * QP + 64 + 8 * j) = *(const u32x4*)(p + 64 + 8 * j); }
__device__ __forceinline__ void gla_load_vt(LAS bf16* VT, const bf16* vsrc  ) {
    const int tid = tid_now(), e = tid >> 1, hf = tid & 1;
    const bf16* p = vsrc + (size_t)e * SEQ + 32 * hf;
#pragma unroll
    for (int q = 0; q < 4; ++q) *(LAS u32x4*)(VT + e * VP + 32 * hf + 8 * q) = *(const u32x4*)(p + 8 * q);
}
__device__ __forceinline__ void gla_stepA(LAS unsigned char* lds, int item, const bf16* proj, const bf16* vtg, const float* glr, const float* W2, const float* b2, bf16* dST, float* decay) {
    const int tid = tid_now(), lane = tid & 63, w = tid >> 6, fr = lane & 15, fq = lane >> 4;
    const int bb = item >> 7, hg = (item >> 5) & 3, n = item & 31, R0 = bb * SEQ + n * 64;
    LAS bf16* KDT = (LAS bf16*)(lds + GA_KDT);
    LAS bf16* KR = (LAS bf16*)(lds + GA_KRAW); LAS float* glrs = (LAS float*)(lds + GA_GLR);
    LAS bf16* VT = (LAS bf16*)(lds + GA_VT); LAS float* tot = (LAS float*)(lds + GA_TOT);
    const int d = tid & 127, g = tid >> 7;
    float wcol[16];
#pragma unroll
    for (int r = 0; r < 16; ++r) wcol[r] = W2[r * 512 + hg * 128 + d];
    const float wbias = b2[hg * 128 + d];
    gla_stage_glr(glrs, glr, R0, tid);
    gla_stage_raw(KR, proj + (size_t)R0 * PROJW + 3584 + hg * 128, PROJW, tid);
    gla_load_vt(VT, vtg + (size_t)(bb * 4 + hg) * 256 * SEQ + n * 64);
    __syncthreads();
    float b[16], blast;
    gla_logdecay(b, blast, glrs, wcol, wbias, d, g, tot);
    if (g == 0) decay[(size_t)item * 128 + d] = __expf(blast);
    { float kd[16];
#pragma unroll
      for (int ii = 0; ii < 16; ++ii) kd[ii] = bf2f(KR[(16 * g + ii) * QP + d]) * __expf(blast - b[ii]);
      u32x4 p0, p1; p0.x = pk2(kd[0], kd[1]); p0.y = pk2(kd[2], kd[3]); p0.z = pk2(kd[4], kd[5]); p0.w = pk2(kd[6], kd[7]);
      p1.x = pk2(kd[8], kd[9]); p1.y = pk2(kd[10], kd[11]); p1.z = pk2(kd[12], kd[13]); p1.w = pk2(kd[14], kd[15]);
      *(LAS u32x4*)(KDT + d * VP + 16 * g) = p0; *(LAS u32x4*)(KDT + d * VP + 16 * g + 8) = p1; }
    __syncthreads();
    f32x4 acc[2][8];
#pragma unroll
    for (int eb = 0; eb < 2; ++eb)
#pragma unroll
        for (int db = 0; db < 8; ++db) acc[eb][db] = (f32x4){0.f, 0.f, 0.f, 0.f};
#pragma unroll
    for (int ks = 0; ks < 2; ++ks) { bf16x8 vf[2];
#pragma unroll
        for (int eb = 0; eb < 2; ++eb) vf[eb] = *(const LAS bf16x8*)(VT + (32 * w + 16 * eb + fr) * VP + 32 * ks + 8 * fq);
#pragma unroll
        for (int db = 0; db < 8; ++db) { const bf16x8 kf = *(const LAS bf16x8*)(KDT + (16 * db + fr) * VP + 32 * ks + 8 * fq);
#pragma unroll
            for (int eb = 0; eb < 2; ++eb) MMA16(kf, vf[eb], acc[eb][db]); } }
    bf16* dst = dST + (size_t)item * 32768;
#pragma unroll
    for (int eb = 0; eb < 2; ++eb)
#pragma unroll
        for (int db = 0; db < 8; ++db) { u32x2 ov; ov.x = pk2(acc[eb][db][0], acc[eb][db][1]); ov.y = pk2(acc[eb][db][2], acc[eb][db][3]);
            *(u32x2*)(dst + (size_t)(32 * w + 16 * eb + fr) * 128 + 16 * db + 4 * fq) = ov; }
    __syncthreads();
}
__device__ __forceinline__ void gla_stepC(LAS unsigned char* lds, int item, const bf16* proj, const bf16* vtg, const float* glr, const float* W2, const float* b2, const bf16* sT, const float* gout, bf16* mix) {
    const int tid = tid_now(), lane = tid & 63, w = tid >> 6, fr = lane & 15, fq = lane >> 4;
    const int bb = item >> 7, hg = (item >> 5) & 3, n = item & 31, R0 = bb * SEQ + n * 64;
    LAS bf16* QE = (LAS bf16*)(lds + GL_QE); LAS bf16* KE = (LAS bf16*)(lds + GL_KE); LAS bf16* VT = (LAS bf16*)(lds + GL_VT); LAS bf16* AS = (LAS bf16*)(lds + GL_AS);
    LAS float* tot = (LAS float*)(lds + GL_TOT); LAS float* red = (LAS float*)(lds + GL_RED); LAS float* glrs = (LAS float*)(lds + GL_GLR);
    const int d = tid & 127, g = tid >> 7;
    float wcol[16];
#pragma unroll
    for (int r = 0; r < 16; ++r) wcol[r] = W2[r * 512 + hg * 128 + d];
    const float wbias = b2[hg * 128 + d];
    const bf16* sp = sT + (size_t)item * 32768;
    bf16x8 sfr[4][2];
#pragma unroll
    for (int ks = 0; ks < 4; ++ks)
#pragma unroll
        for (int eb = 0; eb < 2; ++eb) sfr[ks][eb] = *(const bf16x8*)(sp + (size_t)(32 * w + 16 * eb + fr) * 128 + 32 * ks + 8 * fq);
    u32x2 rgv[4][2]; f32x4 gnv[2];
#pragma unroll
    for (int eb = 0; eb < 2; ++eb) { gnv[eb] = *(const f32x4*)(gout + 32 * w + 16 * eb + 4 * fq);
#pragma unroll
        for (int ib = 0; ib < 4; ++ib) rgv[ib][eb] = *(const u32x2*)(proj + (size_t)(R0 + 16 * ib + fr) * PROJW + 5120 + hg * 256 + 32 * w + 16 * eb + 4 * fq); }
    gla_stage_glr(glrs, glr, R0, tid);
    gla_stage_raw(QE, proj + (size_t)R0 * PROJW + 3072 + hg * 128, PROJW, tid);
    gla_stage_raw(KE, proj + (size_t)R0 * PROJW + 3584 + hg * 128, PROJW, tid);
    gla_load_vt(VT, vtg + (size_t)(bb * 4 + hg) * 256 * SEQ + n * 64);
    __syncthreads();
    float b[16], blast;
    gla_logdecay(b, blast, glrs, wcol, wbias, d, g, tot);
    {
#pragma unroll
      for (int ii = 0; ii < 16; ++ii) { const float eb = __expf(b[ii]); const int o_ = (16 * g + ii) * QP + d;
          QE[o_] = f2bf(bf2f(QE[o_]) * 0.08838834764831845f * eb);
          KE[o_] = f2bf(bf2f(KE[o_]) * __builtin_amdgcn_rcpf(eb)); } }
    __syncthreads();
    { const int ib = w >> 1;
#pragma unroll
      for (int jj = 0; jj < 2; ++jj) { const int jb = 2 * (w & 1) + jj; f32x4 a = (f32x4){0.f, 0.f, 0.f, 0.f};
#pragma unroll
          for (int ks = 0; ks < 4; ++ks) { const bf16x8 kf = *(const LAS bf16x8*)(KE + (16 * jb + fr) * QP + 32 * ks + 8 * fq); const bf16x8 qf = *(const LAS bf16x8*)(QE + (16 * ib + fr) * QP + 32 * ks + 8 * fq); MMA16(kf, qf, a); }
          const int i = 16 * ib + fr, j0 = 16 * jb + 4 * fq;
          u32x2 ov; ov.x = pk2(j0 <= i ? a[0] : 0.f, j0 + 1 <= i ? a[1] : 0.f); ov.y = pk2(j0 + 2 <= i ? a[2] : 0.f, j0 + 3 <= i ? a[3] : 0.f);
          *(LAS u32x2*)(AS + i * VP + j0) = ov; } }
    __syncthreads();
    f32x4 acc[2][4];
#pragma unroll
    for (int eb = 0; eb < 2; ++eb)
#pragma unroll
        for (int ib = 0; ib < 4; ++ib) acc[eb][ib] = (f32x4){0.f, 0.f, 0.f, 0.f};
#pragma unroll
    for (int ks = 0; ks < 2; ++ks) { bf16x8 vf[2];
#pragma unroll
        for (int eb = 0; eb < 2; ++eb) vf[eb] = *(const LAS bf16x8*)(VT + (32 * w + 16 * eb + fr) * VP + 32 * ks + 8 * fq);
#pragma unroll
        for (int ib = 0; ib < 4; ++ib) { const bf16x8 af = *(const LAS bf16x8*)(AS + (16 * ib + fr) * VP + 32 * ks + 8 * fq);
#pragma unroll
            for (int eb = 0; eb < 2; ++eb) MMA16(vf[eb], af, acc[eb][ib]); } }
#pragma unroll
    for (int ks = 0; ks < 4; ++ks) {
#pragma unroll
        for (int ib = 0; ib < 4; ++ib) { const bf16x8 qf = *(const LAS bf16x8*)(QE + (16 * ib + fr) * QP + 32 * ks + 8 * fq);
#pragma unroll
            for (int eb = 0; eb < 2; ++eb) MMA16(sfr[ks][eb], qf, acc[eb][ib]); } }
#pragma unroll
    for (int ib = 0; ib < 4; ++ib) { float q = 0.f;
#pragma unroll
        for (int eb = 0; eb < 2; ++eb) q += (acc[eb][ib][0] * acc[eb][ib][0] + acc[eb][ib][1] * acc[eb][ib][1]) + (acc[eb][ib][2] * acc[eb][ib][2] + acc[eb][ib][3] * acc[eb][ib][3]);
        q += __shfl_xor(q, 16); q += __shfl_xor(q, 32);
        if (fq == 0) red[w * 64 + 16 * ib + fr] = q; }
    __syncthreads();
#pragma unroll
    for (int ib = 0; ib < 4; ++ib) { float q = 0.f;
#pragma unroll
        for (int ww = 0; ww < 8; ++ww) q += red[ww * 64 + 16 * ib + fr];
        const float rs = __builtin_amdgcn_rsqf(q * (1.f / 256.f) + EPS);
        const size_t row = (size_t)(R0 + 16 * ib + fr);
#pragma unroll
        for (int eb = 0; eb < 2; ++eb) { const int e = 32 * w + 16 * eb + 4 * fq;
            const u32x2 rg = rgv[ib][eb]; const f32x4 gn = gnv[eb];
            const float r0 = bflo(rg.x), r1 = bfhi(rg.x), r2 = bflo(rg.y), r3 = bfhi(rg.y);
            u32x2 ov; ov.x = pk2(acc[eb][ib][0] * rs * gn[0] * pg8::silu_f(r0), acc[eb][ib][1] * rs * gn[1] * pg8::silu_f(r1));
            ov.y = pk2(acc[eb][ib][2] * rs * gn[2] * pg8::silu_f(r2), acc[eb][ib][3] * rs * gn[3] * pg8::silu_f(r3));
            *(u32x2*)(mix + row * DM + 1024 + hg * 256 + e) = ov; } }
    __syncthreads();
}

__global__ void __launch_bounds__(512, 2) fwd_mega(Args args) {
    extern __shared__ __attribute__((aligned(16))) unsigned char lds_raw[];
    LAS unsigned char* lds = (LAS unsigned char*)lds_raw;
    cg::grid_group grid = cg::this_grid();
    const int G = gridDim.x, bx = blockIdx.x;
    LAS unsigned long long* ptab = (LAS unsigned long long*)(lds + 147200);
    { const int tid = threadIdx.x;
    if (tid < 26) ptab[tid] = (unsigned long long)args.in[tid];
    if (tid == 26) ptab[26] = (unsigned long long)args.out;
    if (tid == 27) ptab[27] = (unsigned long long)args.ws;
    if (tid == 28) { ((volatile LAS unsigned*)(lds + 147200 + 240))[0] = 0u; ((volatile LAS unsigned*)(lds + 147200 + 240))[1] = 0u; } }
    __syncthreads();
    const bool coop = (args.ph_hi - args.ph_lo) > 1;
    XcdBarrier xbar; xbar.bar = (unsigned*)(args.ws + WS_CTL); xbar.x = 0; xbar.st = nullptr;
    if (coop) xbar = xcd_barrier_post((unsigned*)(args.ws + WS_CTL), (volatile LAS unsigned*)(lds + 147200 + 240));
#define INP(i) ((const float*)ldptr(ptab, (i)))
    for (int ph = args.ph_lo; ph < args.ph_hi; ++ph) {
    if (ph == 9) continue;
    const int tid = tid_now(), lane = tid & 63, wave = __builtin_amdgcn_readfirstlane(tid >> 6);
    const int gw = bx * 8 + wave, NGW = G * 8;
    unsigned char* ws = (unsigned char*)ldptr(ptab, 27); float* xres = (float*)ldptr(ptab, 26);
    bf16* Wgu1 = (bf16*)(ws + WS_WGU1); bf16* Wd1 = (bf16*)(ws + WS_WD1); bf16* Win = (bf16*)(ws + WS_WIN); bf16* Wout = (bf16*)(ws + WS_WOUT);
    bf16* Wq = (bf16*)(ws + WS_WQ); bf16* Wkv = (bf16*)(ws + WS_WKV); bf16* Wo = (bf16*)(ws + WS_WO); bf16* Wgu2 = (bf16*)(ws + WS_WGU2); bf16* Wd2 = (bf16*)(ws + WS_WD2);
    bf16* ACT = (bf16*)(ws + WS_R1); bf16* PROJ = (bf16*)(ws + WS_R1); bf16* Hb = (bf16*)(ws + WS_H)  ; bf16* ST = (bf16*)((unsigned char*)xres + 16 * MiB);
    bf16* MIX = (bf16*)(ws + WS_MIX); bf16* DST = (bf16*)(ws + WS_DST); bf16* MEMN = (bf16*)(ws + WS_MEMN); bf16* KVX = (bf16*)(ws + WS_KVX);
    bf16* OX = (bf16*)(ws + WS_OX);
    bf16* VTA = (bf16*)xres;
    bf16* VTG = (bf16*)(ws + WS_QX);
    float* SSQ = (float*)(ws + WS_SSQ); float* GLR = (float*)(ws + WS_GLR); float* DECAY = (float*)(ws + WS_DECAY); float* ROPE = (float*)(ws + WS_ROPE);
        if (ph == 0) {
            LAS float* scr = (LAS float*)(lds + wave * 17664);
            constexpr int I_G = 32 * 88, I_D = 88 * 32, I_IN = 32 * 97, I_OUT = 32 * 32, I_Q = 32 * 8, I_O = 8 * 32;
            constexpr int NIT = 3 * I_G + I_IN + I_OUT + 3 * I_Q + I_O; (void)I_D;
            for (int it = gw; it < NIT; it += NGW) {
                int r = it;
                if (r < I_G) { p0_tr(INP(3), DM, DFF, Wgu1, 256, 0, scr, r, lane, INP(2)); continue; } r -= I_G;
                if (r < I_G) { p0_tr(INP(4), DM, DFF, Wgu1, 256, 128, scr, r, lane, INP(2)); continue; } r -= I_G;
                if (r < I_IN) { p0_tr(INP(7), DM, MIXC, Win, 128, 0, scr, r, lane, INP(6)); continue; } r -= I_IN;
                if (r < I_OUT) { p0_tr(INP(13), DM, DM, Wout, 128, 0, scr, r, lane); continue; } r -= I_OUT;
                if (r < I_Q) { p0_tr(INP(16), DM, 512, Wq, 128, 0, scr, r, lane, INP(14)); continue; } r -= I_Q;
                if (r < I_Q) { p0_tr(INP(17), DM, 512, Wkv, 128, 0, scr, r, lane); continue; } r -= I_Q;
                if (r < I_Q) { p0_tr(INP(18), DM, 512, Wkv, 128, 512, scr, r, lane); continue; } r -= I_Q;
                if (r < I_O) { p0_tr(INP(21), 512, DM, Wo, 128, 0, scr, r, lane); continue; } r -= I_O;
                p0_tr(INP(24), DM, DFF, Wgu2, 256, 128, scr, r, lane, INP(22));
            }
            for (int idx = bx * 512 + tid; idx < SEQ * 64; idx += G * 512) { const int pos = idx >> 6, i = idx & 63;
                const float inv = exp2f(-(float)i * (13.287712379549449f / 64.0f)); const float ang = (float)pos * inv;
                const double rev = (double)ang * 0.15915494309189535; const float fr_ = (float)(rev - floor(rev));
                ROPE[idx] = __builtin_amdgcn_cosf(fr_); ROPE[SEQ * 64 + idx] = __builtin_amdgcn_sinf(fr_); }
            for (int m = gw; m < TOK + 4 * NMEM; m += NGW) {
                const bool ismem = m >= TOK; const float* src = ismem ? INP(1) + (size_t)(m - TOK) * DM : INP(0) + (size_t)m * DM;
                const float* gain = INP(15);
                f32x4 v[8]; float s = 0.f;
#pragma unroll
                for (int j = 0; j < 8; ++j) { v[j] = ismem ? *(const f32x4*)(src + 4 * lane + 256 * j) : __builtin_nontemporal_load((const f32x4*)(src + 4 * lane + 256 * j)); s += (v[j][0] * v[j][0] + v[j][1] * v[j][1]) + (v[j][2] * v[j][2] + v[j][3] * v[j][3]); }
                s = wave_sum(s);
                const float rs = ismem ? __builtin_amdgcn_rsqf(s * (1.f / 2048.f) + EPS) : 1.0f;
                bf16* dst = ismem ? MEMN + (size_t)(m - TOK) * DM : Hb + (size_t)m * DM;
#pragma unroll
                for (int j = 0; j < 8; ++j) { const f32x4 gv = ismem ? *(const f32x4*)(gain + 4 * lane + 256 * j) : (f32x4){1.f, 1.f, 1.f, 1.f};
                    u32x2 ov; ov.x = pk2(v[j][0] * rs * gv[0], v[j][1] * rs * gv[1]); ov.y = pk2(v[j][2] * rs * gv[2], v[j][3] * rs * gv[3]);
                    *(u32x2*)(dst + 4 * lane + 256 * j) = ov; }
                if (!ismem && lane < 32) SSQ[(size_t)m * 32 + lane] = (lane == 0) ? s : 0.f;
            }
        } else if (ph == 1 || ph == 12) {
            pg8::Gemm g{Hb, ph == 1 ? Wgu1 : Wgu2, TOK, 2 * DFF, DM}; pg8::StaticOrder S; S.init(TOK, 2 * DFF, G, bx);
            pg8::EpiSwiglu E{ACT, DFF, SSQ};
            pg8::gemm_phase<pg8::EpiSwiglu, pg8::StaticOrder, true, true>(lds, g, S, E);
            if (ph == 1) {
                __syncthreads();
                pg8::Gemm g2{MEMN, Wkv, 4 * NMEM, 1024, DM}; pg8::StaticOrder S2; S2.init(4 * NMEM, 1024, G, (bx + G - 128) % G);
                pg8::EpiScale E2{KVX, 1024, nullptr};
                pg8::gemm_phase<pg8::EpiScale, pg8::StaticOrder, true, true>(lds, g2, S2, E2);
            }
            { const int first = (ph == 1) ? 144 : 128;
              if (G == 256 && bx >= first) { __syncthreads(); LAS float* scr = (LAS float*)(lds + wave * 17664);
                  for (int it = (bx - first) * 8 + wave; it < 88 * 32; it += (256 - first) * 8) p0_tr(ph == 1 ? INP(5) : INP(25), DFF, DM, ph == 1 ? Wd1 : Wd2, 128, 0, scr, it, lane);
                  if (ph == 1) for (int it = (bx - first) * 8 + wave; it < 32 * 88; it += (256 - first) * 8) p0_tr(INP(23), DM, DFF, Wgu2, 256, 0, scr, it, lane, INP(22)); }
              else if (G != 256) { __syncthreads(); LAS float* scr = (LAS float*)(lds + wave * 17664);
                  for (int it = gw; it < 88 * 32; it += NGW) p0_tr(ph == 1 ? INP(5) : INP(25), DFF, DM, ph == 1 ? Wd1 : Wd2, 128, 0, scr, it, lane);
                  if (ph == 1) for (int it = gw; it < 32 * 88; it += NGW) p0_tr(INP(23), DM, DFF, Wgu2, 256, 0, scr, it, lane, INP(22)); } }
        } else if (ph == 2 || ph == 8 || ph == 11 || ph == 13) {
            const bf16* A = (ph == 2 || ph == 13) ? ACT : (ph == 8 ? MIX : OX);
            const bf16* Bt = ph == 2 ? Wd1 : (ph == 8 ? Wout : (ph == 11 ? Wo : Wd2));
            const int K = (ph == 2 || ph == 13) ? DFF : (ph == 8 ? DM : 512);
            pg8::Gemm g{A, Bt, TOK, DM, K}; pg8::StaticOrder S; S.init(TOK, DM, G, bx);
            pg8::EpiResid E{(const float*)nullptr  , Hb, ph == 13 ? xres : (float*)nullptr, ph == 13 ? nullptr : SSQ, (ph == 2 || ph == 13) ? 0.5f : 1.0f};
            pg8::gemm_phase<pg8::EpiResid, pg8::StaticOrder, true, true>(lds, g, S, E);
        } else if (ph == 3) {
            {
                pg8::Gemm g{Hb, Win, TOK, PROJW, DM};
                pg8::StaticOrder S; S.init(g.M, g.N, G, bx);
                pg8::EpiScale E{PROJ, PROJW, SSQ};
                pg8::gemm_phase<pg8::EpiScale, pg8::StaticOrder, true, true>(lds, g, S, E);
                __syncthreads();
            }
            if (ph == 3) {
                const int fr = lane & 15, fq = lane >> 4;
                LAS float* red = (LAS float*)lds;
                for (int rb = bx; rb < TOK / 32; rb += G) {
                    f32x4 a2[2] = {(f32x4){0.f, 0.f, 0.f, 0.f}, (f32x4){0.f, 0.f, 0.f, 0.f}};
#pragma unroll
                    for (int ks = 0; ks < 8; ++ks) { const int k = wave * 256 + 32 * ks + 8 * fq;
                        const bf16x8 wf = *(const bf16x8*)(Win + (size_t)(PROJW + fr) * DM + k);
#pragma unroll
                        for (int r2 = 0; r2 < 2; ++r2) { const bf16x8 hf = *(const bf16x8*)(Hb + (size_t)(rb * 32 + 16 * r2 + fr) * DM + k); MMA16(wf, hf, a2[r2]); } }
#pragma unroll
                    for (int r2 = 0; r2 < 2; ++r2) *(LAS f32x4*)(red + (wave * 32 + 16 * r2 + fr) * 16 + 4 * fq) = a2[r2];
                    __syncthreads();
                    { const int r = tid >> 4, c = tid & 15; float s = 0.f;
#pragma unroll
                      for (int ww = 0; ww < 8; ++ww) s += red[(ww * 32 + r) * 16 + c];
                      const int row = rb * 32 + r; float q = 0.f;
#pragma unroll
                      for (int e = 0; e < 32; ++e) q += SSQ[(size_t)row * 32 + e];
                      GLR[(size_t)row * 16 + c] = s * __builtin_amdgcn_rsqf(q * (1.f / 2048.f) + EPS); }
                    __syncthreads();
                }
            }
        } else if (ph == 4) {
            const float* qn = INP(8); const float* kn = INP(9);
            const int hs = lane >> 4, l = lane & 15;
#define PREP_ONE(p, a, b, cs, sn, hh) do { \
                    float x1[4] = {bflo(a.x), bfhi(a.x), bflo(a.y), bfhi(a.y)}, x2[4] = {bflo(b.x), bfhi(b.x), bflo(b.y), bfhi(b.y)}; \
                    float sq = 0.f; \
                    _Pragma("unroll") for (int e = 0; e < 4; ++e) sq += x1[e] * x1[e] + x2[e] * x2[e]; \
                    sq += __shfl_xor(sq, 1); sq += __shfl_xor(sq, 2); sq += __shfl_xor(sq, 4); sq += __shfl_xor(sq, 8); \
                    const float rs = __builtin_amdgcn_rsqf(sq * (1.f / 128.f) + EPS); \
                    const float* gn = ((hh) < 8) ? qn : kn; const float sc = ((hh) < 8) ? QSCALE : 1.0f; \
                    const f32x4 g1 = *(const f32x4*)(gn + 4 * l), g2 = *(const f32x4*)(gn + 64 + 4 * l); \
                    float o1[4], o2[4]; \
                    _Pragma("unroll") for (int e = 0; e < 4; ++e) { const float y1 = x1[e] * rs * g1[e], y2 = x2[e] * rs * g2[e]; o1[e] = (y1 * cs[e] - y2 * sn[e]) * sc; o2[e] = (y2 * cs[e] + y1 * sn[e]) * sc; } \
                    u32x2 oa, ob; oa.x = pk2(o1[0], o1[1]); oa.y = pk2(o1[2], o1[3]); ob.x = pk2(o2[0], o2[1]); ob.y = pk2(o2[2], o2[3]); \
                    *(u32x2*)(p) = oa; *(u32x2*)((p) + 64) = ob; } while (0)
#define PREP_LOAD(k, idx) const int row##k = (idx) >> 2, hh##k = ((idx) & 3) * 4 + hs, pos##k = row##k & (SEQ - 1); bf16* p##k = PROJ + (size_t)row##k * PROJW + hh##k * 128 + 4 * l; \
                    const u32x2 a##k = *(const u32x2*)p##k, b##k = *(const u32x2*)(p##k + 64); const f32x4 cs##k = *(const f32x4*)(ROPE + pos##k * 64 + 4 * l), sn##k = *(const f32x4*)(ROPE + SEQ * 64 + pos##k * 64 + 4 * l)
            int idx0 = gw;
            for (; idx0 + 3 * NGW < TOK * 4; idx0 += 4 * NGW) {
                PREP_LOAD(0, idx0); PREP_LOAD(1, idx0 + NGW); PREP_LOAD(2, idx0 + 2 * NGW); PREP_LOAD(3, idx0 + 3 * NGW);
                PREP_ONE(p0, a0, b0, cs0, sn0, hh0); PREP_ONE(p1, a1, b1, cs1, sn1, hh1); PREP_ONE(p2, a2, b2, cs2, sn2, hh2); PREP_ONE(p3, a3, b3, cs3, sn3, hh3);
            }
            for (; idx0 < TOK * 4; idx0 += NGW) { PREP_LOAD(0, idx0); PREP_ONE(p0, a0, b0, cs0, sn0, hh0); }
#undef PREP_ONE
#undef PREP_LOAD
            { LAS bf16* T = (LAS bf16*)lds; const int r = tid >> 3, j = tid & 7, dd = tid & 127, kq = tid >> 7;
              int idx = bx; u32x4 ta = {0u, 0u, 0u, 0u}, tb = {0u, 0u, 0u, 0u};
              if (idx < 2048) { const int rem = idx & 1023, b_ = rem >> 8, hq = (rem >> 5) & 7, st = rem & 31; const bf16* p = PROJ + (size_t)(b_ * SEQ + 64 * st + r) * PROJW + ((idx >> 10) ? 4096 : 2048) + 128 * hq + 8 * j;
                  ta = *(const u32x4*)p; tb = *(const u32x4*)(p + 64); }
              for (; idx < 2048; idx += G) {
                  *(LAS u32x4*)(T + r * QP + 8 * j) = ta; *(LAS u32x4*)(T + r * QP + 64 + 8 * j) = tb;
                  __syncthreads();
                  if (idx + G < 2048) { const int i2 = idx + G, rem = i2 & 1023, b_ = rem >> 8, hq = (rem >> 5) & 7, st = rem & 31; const bf16* p = PROJ + (size_t)(b_ * SEQ + 64 * st + r) * PROJW + ((i2 >> 10) ? 4096 : 2048) + 128 * hq + 8 * j;
                      ta = *(const u32x4*)p; tb = *(const u32x4*)(p + 64); }
                  unsigned v[16];
#pragma unroll
                  for (int i = 0; i < 16; ++i) { const int key = (idx >> 10) ? (16 * kq + i) : (32 * (kq >> 1) + 16 * ((i >> 2) & 1) + 8 * (kq & 1) + 4 * (i >> 3) + (i & 3)); v[i] = T[key * QP + dd]; }
                  u32x4 o0, o1; o0.x = v[0] | (v[1] << 16); o0.y = v[2] | (v[3] << 16); o0.z = v[4] | (v[5] << 16); o0.w = v[6] | (v[7] << 16);
                  o1.x = v[8] | (v[9] << 16); o1.y = v[10] | (v[11] << 16); o1.z = v[12] | (v[13] << 16); o1.w = v[14] | (v[15] << 16);
                  { const int rem = idx & 1023, b_ = rem >> 8, hq = (rem >> 5) & 7, st = rem & 31;
                    bf16* dst = ((idx >> 10) ? VTG : VTA) + ((size_t)(b_ * 8 + hq) * 128 + dd) * SEQ + 64 * st + 16 * kq;
                    *(u32x4*)dst = o0; *(u32x4*)(dst + 8) = o1; }
                  __syncthreads();
              } }
        } else if (ph == 5) {
            for (int item = bx; item < 512; item += G) gla_stepA(lds, item, PROJ, VTG, GLR, INP(10), INP(11), DST, DECAY);
            __syncthreads();
            const float bref5 = attn_logit_bound(INP(8), INP(9), lane, 1.5849625007211562f);
            attn_build_bias(lds, tid, bref5);
            __syncthreads();
            for (int c0 = bx; c0 < 256; c0 += G) { const int c = (G == 256) ? ((c0 & 7) * 32 + (c0 >> 3)) : c0;
                const int bh = c >> 3, s = c & 7, bb = bh >> 3, hh = bh & 7;
#pragma unroll 1
                for (int k = 0; k < 2; ++k) { const int qb = k == 0 ? s : 15 - s; const int q0 = qb * 128; const size_t R0 = (size_t)bb * SEQ;
                    attn_item<0>(lds, PROJ + (R0 + q0) * PROJW + hh * 128, PROJW, PROJ + R0 * PROJW + 1024 + hh * 128, VTA + (size_t)(bb * 8 + hh) * 128 * SEQ, PROJW,
                                 (q0 + 128) / 64, q0, MIX + (R0 + q0) * DM + hh * 128, DM, nullptr, nullptr, nullptr, nullptr, 0, bref5);
                    __syncthreads(); } }
        } else if (ph == 6) {
            for (int idx = bx * 512 + tid; idx < 16 * 256 * 32; idx += G * 512) { const int bh = idx >> 13, rem = idx & 8191;
                f32x4 st = (f32x4){0.f, 0.f, 0.f, 0.f};
#pragma unroll 16
                for (int n = 0; n < 32; ++n) { const size_t item = (size_t)bh * 32 + n;
                    const u32x2 dsv = *(const u32x2*)(DST + item * 32768 + (size_t)rem * 4); const f32x4 dc = *(const f32x4*)(DECAY + item * 128 + (rem & 31) * 4);
                    u32x2 ov; ov.x = pk2(st[0], st[1]); ov.y = pk2(st[2], st[3]); *(u32x2*)(ST + item * 32768 + (size_t)rem * 4) = ov;
                    st[0] = dc[0] * st[0] + bflo(dsv.x); st[1] = dc[1] * st[1] + bfhi(dsv.x); st[2] = dc[2] * st[2] + bflo(dsv.y); st[3] = dc[3] * st[3] + bfhi(dsv.y); } }
        } else if (ph == 7) {
            for (int item = bx; item < 512; item += G) gla_stepC(lds, item, PROJ, VTG, GLR, INP(10), INP(11), ST, INP(12), MIX);
        } else if (ph == 10) {
            const float bref10 = attn_logit_bound(INP(19), INP(20), lane, 0.f);
            for (int item = bx; item < 256; item += G) { const int bb = item >> 6, hh = (item >> 4) & 3, qb = item & 15; const size_t R0 = (size_t)bb * SEQ + qb * 128;
                attn_item<2>(lds, Hb + R0 * DM, DM, KVX + (size_t)bb * NMEM * 1024 + hh * 128, KVX + (size_t)bb * NMEM * 1024 + 512 + hh * 128, 1024,
                             4, 0, OX + R0 * 512 + hh * 128, 512, INP(19), INP(20), Wq + (size_t)hh * 128 * DM, SSQ, (int)R0, bref10);
                __syncthreads(); }
        }
        if (ph + 1 < args.ph_hi) { if (args.ph_lo < 0) grid.sync();   xcd_barrier(xbar); }
    }
}

#ifndef MK_PER_PHASE
#define MK_PER_PHASE 0
#endif
extern "C" void kernel_launch(void* const* d_in, const int* in_sizes, int n_in, void* d_out, int out_size, void* d_ws, size_t ws_size, hipStream_t stream) {
    static int grid = 0;
    if (grid == 0) {
        if (n_in != 26 || out_size != TOK * DM || ws_size < WS_END) { fprintf(stderr, "kernel_launch: unexpected problem (n_in %d out %d ws %zu)\n", n_in, out_size, ws_size); grid = -1; return; }
        int dev = 0, cus = 0, per_cu = 0;
        (void)hipGetDevice(&dev); (void)hipDeviceGetAttribute(&cus, hipDeviceAttributeMultiprocessorCount, dev);
        if (hipFuncSetAttribute((const void*)fwd_mega, hipFuncAttributeMaxDynamicSharedMemorySize, LDS_BYTES) != hipSuccess) { fprintf(stderr, "kernel_launch: hipFuncSetAttribute failed\n"); grid = -1; return; }
        if (hipOccupancyMaxActiveBlocksPerMultiprocessor(&per_cu, (const void*)fwd_mega, 512, LDS_BYTES) != hipSuccess || per_cu < 1) { fprintf(stderr, "kernel_launch: occupancy query says %d\n", per_cu); per_cu = 1; }
        (void)hipGetLastError();
        grid = cus * 1;
        if (per_cu < 1) grid = -1;
    }
    if (grid < 0) return;
    if (hipMemsetAsync((char*)d_ws + WS_CTL, 0, CTL_ZERO_BYTES, stream) != hipSuccess) { fprintf(stderr, "kernel_launch: memset of barrier words failed\n"); return; }
    Args a{};
    for (int i = 0; i < 26; ++i) a.in[i] = (const float*)d_in[i];
    a.out = (float*)d_out; a.ws = (unsigned char*)d_ws;
#if MK_PER_PHASE
    for (int ph = 0; ph < NPHASE; ++ph) { a.ph_lo = ph; a.ph_hi = ph + 1; hipLaunchKernelGGL(fwd_mega, dim3(grid), dim3(512), LDS_BYTES, stream, a); }
#else
    a.ph_lo = 0; a.ph_hi = NPHASE;
    void* kargs[] = {&a};
    hipError_t e = hipLaunchCooperativeKernel((const void*)fwd_mega, dim3(grid), dim3(512), kargs, LDS_BYTES, stream);
    if (e != hipSuccess) fprintf(stderr, "cooperative launch failed: %s (grid %d)\n", hipGetErrorString(e), grid);
#endif
}
```

```cpp
#include <hip/hip_runtime.h>
#include <hip/hip_cooperative_groups.h>
#include <cstdio>
#include <cstdint>
namespace cg = cooperative_groups;
__device__ __forceinline__ int tid_now() { int t = threadIdx.x; asm volatile("" : "+v"(t)); return t; }
namespace pg8 {
#define PG8_LAS __attribute__((address_space(3)))
typedef unsigned short bf16_t;
typedef short bf16x8 __attribute__((ext_vector_type(8)));
typedef float f32x4 __attribute__((ext_vector_type(4)));
typedef unsigned u32x4 __attribute__((ext_vector_type(4)));
constexpr int BM = 256, BK = 64, HALF = 128, HTB = HALF * BK * 2  , STAGE_BYTES = 8 * HTB, NXCD = 8, WGM = 8;

__host__ __device__ __forceinline__ int lds_byte(int r, int c) { const int st = (r >> 4) * 2 + (c >> 5), rr = r & 15, cc = c & 31, ob = rr * 64 + cc * 2; return st * 1024 + (ob ^ (((ob >> 9) & 1) << 5)); }
__host__ __device__ __forceinline__ void stage_rc(int b, int& R, int& C) { const int st = b / 1024, sb = b % 1024, swz = sb ^ (((sb >> 9) & 1) << 5); R = (st >> 1) * 16 + swz / 64; C = (st & 1) * 32 + (swz % 64) / 2; }
__host__ __device__ __forceinline__ int perm32(int rho) { const int n = rho >> 4, i = rho & 15; return 8 * (i >> 2) + 4 * n + (i & 3); }

struct Unit { int pm, pn; };
struct Gemm { const bf16_t* A; const bf16_t* Bt; int M, N, K; };

struct StaticOrder {
    int nM, nN, nwg, G, c;
    __host__ __device__ void init(int M, int N, int G_, int c_) { nM = M / BM; nN = N / BM; nwg = nM * nN; G = G_; c = c_; }
    __host__ __device__ bool next(int i, Unit& u) const {
        const long L = (long)i * G + c; if (L >= nwg) return false;
        int wgid = (int)L; { const int q = nwg / NXCD, r = nwg % NXCD, xcd = wgid % NXCD, off = wgid / NXCD; wgid = (xcd < r ? xcd * (q + 1) : r * (q + 1) + (xcd - r) * q) + off; }
        const int nig = WGM * nN, gid = wgid / nig, fm = gid * WGM, gsz = (nM - fm) < WGM ? (nM - fm) : WGM;
        u.pm = fm + ((wgid % nig) % gsz); u.pn = (wgid % nig) / gsz; return true;
    }
    __device__ __forceinline__ void a_ready(const Unit&) const {}
    __device__ __forceinline__ void done(const Unit&) const {}
};

__device__ __forceinline__ unsigned cvt_pk_bf16(float lo, float hi) { unsigned r; asm volatile("v_cvt_pk_bf16_f32 %0, %1, %2" : "=v"(r) : "v"(lo), "v"(hi)); return r; }
__device__ __forceinline__ float row_rs(const float* ssq, int row, int fq) {
    const f32x4 a = *(const f32x4*)(ssq + (size_t)row * 32 + fq * 8), b = *(const f32x4*)(ssq + (size_t)row * 32 + fq * 8 + 4);
    float s = ((a[0] + a[1]) + (a[2] + a[3])) + ((b[0] + b[1]) + (b[2] + b[3]));
    s += __shfl_xor(s, 16); s += __shfl_xor(s, 32);
    return __builtin_amdgcn_rsqf(s * (1.0f / 2048.0f) + 1e-6f);
}
__device__ __forceinline__ float row_ms(const float* ssq, int row, int fq) {
    const f32x4 a = *(const f32x4*)(ssq + (size_t)row * 32 + fq * 8), b = *(const f32x4*)(ssq + (size_t)row * 32 + fq * 8 + 4);
    float s = ((a[0] + a[1]) + (a[2] + a[3])) + ((b[0] + b[1]) + (b[2] + b[3]));
    s += __shfl_xor(s, 16); s += __shfl_xor(s, 32);
    return s * (1.0f / 2048.0f) + 1e-6f;
}
__device__ __forceinline__ float silu_f(float g) { return g * __builtin_amdgcn_rcpf(1.0f + __builtin_amdgcn_exp2f(-1.4426950408889634f * g)); }
struct EpiSwiglu {
    static constexpr bool PERM = true, AFTER_DRAIN = false;
    bf16_t* O; int ldc; const float* ssq;
    __device__ __forceinline__ void operator()(const f32x4 (&acc)[2][2][4][2], const Unit& u, int wr, int wc, int fr, int fq) const {
        const int row0 = u.pm * BM + wr * 64 + fr, col0 = u.pn * HALF + wc * 32 + 8 * fq;
#pragma unroll
        for (int ai = 0; ai < 2; ++ai)
#pragma unroll
            for (int m = 0; m < 4; ++m) { const int row = row0 + ai * HALF + m * 16; const float ms = row_ms(ssq, row, fq);
                const float cexp = -1.4426950408889634f * __builtin_amdgcn_rsqf(ms);
                float v[8];
#pragma unroll
                for (int n = 0; n < 2; ++n)
#pragma unroll
                    for (int i = 0; i < 4; ++i) { const float a = acc[ai][0][m][n][i], b = acc[ai][1][m][n][i];
                        v[n * 4 + i] = (a * b) * __builtin_amdgcn_rcpf(__builtin_fmaf(__builtin_amdgcn_exp2f(a * cexp), ms, ms)); }
                u32x4 w; w.x = cvt_pk_bf16(v[0], v[1]); w.y = cvt_pk_bf16(v[2], v[3]); w.z = cvt_pk_bf16(v[4], v[5]); w.w = cvt_pk_bf16(v[6], v[7]);
                *(u32x4*)(O + (size_t)row * ldc + col0) = w; }
    }
};
struct EpiResid {
    static constexpr bool PERM = true, AFTER_DRAIN = false;
    const float* base32; bf16_t* xb; float* out32; float* ssq_out; float alpha;
    __device__ __forceinline__ void operator()(const f32x4 (&acc)[2][2][4][2], const Unit& u, int wr, int wc, int fr, int fq) const {
        const int row0 = u.pm * BM + wr * 64 + fr, col0 = u.pn * BM + wc * 32 + 8 * fq;
#pragma unroll
        for (int ai = 0; ai < 2; ++ai)
#pragma unroll
            for (int m = 0; m < 4; ++m) { const int row = row0 + ai * HALF + m * 16; float q = 0.f;
#pragma unroll
                for (int bj = 0; bj < 2; ++bj) { const size_t off = (size_t)row * 2048 + col0 + bj * HALF;
                    f32x4 b0, b1;
                    if (base32) { b0 = *(const f32x4*)(base32 + off); b1 = *(const f32x4*)(base32 + off + 4); }
                    else { const u32x4 bw = *(const u32x4*)(xb + off);
                        b0 = (f32x4){__uint_as_float(bw.x << 16), __uint_as_float(bw.x & 0xffff0000u), __uint_as_float(bw.y << 16), __uint_as_float(bw.y & 0xffff0000u)};
                        b1 = (f32x4){__uint_as_float(bw.z << 16), __uint_as_float(bw.z & 0xffff0000u), __uint_as_float(bw.w << 16), __uint_as_float(bw.w & 0xffff0000u)}; }
                    const f32x4 x0 = b0 + acc[ai][bj][m][0] * alpha, x1 = b1 + acc[ai][bj][m][1] * alpha;
                    q += (x0[0] * x0[0] + x0[1] * x0[1]) + (x0[2] * x0[2] + x0[3] * x0[3]) + (x1[0] * x1[0] + x1[1] * x1[1]) + (x1[2] * x1[2] + x1[3] * x1[3]);
                    if (out32) { *(f32x4*)(out32 + off) = x0; *(f32x4*)(out32 + off + 4) = x1; }
                    else { u32x4 w; w.x = cvt_pk_bf16(x0[0], x0[1]); w.y = cvt_pk_bf16(x0[2], x0[3]); w.z = cvt_pk_bf16(x1[0], x1[1]); w.w = cvt_pk_bf16(x1[2], x1[3]);
                        *(u32x4*)(xb + off) = w; } }
                if (ssq_out) { q += __shfl_xor(q, 16); q += __shfl_xor(q, 32); if (fq == 0) ssq_out[(size_t)row * 32 + u.pn * 4 + wc] = q; } }
    }
};
struct EpiScale {
    static constexpr bool PERM = true, AFTER_DRAIN = false;
    bf16_t* O; int ldc; const float* ssq;
    __device__ __forceinline__ void operator()(const f32x4 (&acc)[2][2][4][2], const Unit& u, int wr, int wc, int fr, int fq) const {
        const int row0 = u.pm * BM + wr * 64 + fr, col0 = u.pn * BM + wc * 32 + 8 * fq;
#pragma unroll
        for (int ai = 0; ai < 2; ++ai)
#pragma unroll
            for (int m = 0; m < 4; ++m) { const int row = row0 + ai * HALF + m * 16; const float rs = ssq ? row_rs(ssq, row, fq) : 1.0f;
#pragma unroll
                for (int bj = 0; bj < 2; ++bj) { const f32x4 v0 = acc[ai][bj][m][0] * rs, v1 = acc[ai][bj][m][1] * rs;
                    u32x4 w; w.x = cvt_pk_bf16(v0[0], v0[1]); w.y = cvt_pk_bf16(v0[2], v0[3]); w.z = cvt_pk_bf16(v1[0], v1[1]); w.w = cvt_pk_bf16(v1[2], v1[3]);
                    *(u32x4*)(O + (size_t)row * ldc + col0 + bj * HALF) = w; } }
    }
};
template <class Epi, class Sched, bool ALIGN_EPI = false, bool SP2 = false>
__device__ __forceinline__ void gemm_phase(PG8_LAS unsigned char* lds, const Gemm g, const Sched& S, const Epi& E) {
    const int tid = tid_now(), wid = __builtin_amdgcn_readfirstlane(tid >> 6), lane = tid & 63, wr = wid >> 2, wc = wid & 3, fr = lane & 15, fq = lane >> 4;
    const int K = g.K, nt = K / BK;
    unsigned voffA[2], voffB[2];
#pragma unroll
    for (int i = 0; i < 2; ++i) { int R, C; stage_rc(tid * 16 + i * 8192, R, C); const int Rb = Epi::PERM ? ((R & ~31) + perm32(R & 31)) : R;
        voffA[i] = (unsigned)(R * K + C) * 2u; voffB[i] = (unsigned)(Rb * K + C) * 2u; }
    const size_t kstep = (size_t)(BK * 2);
    const size_t hstep = (size_t)HALF * K * 2;
    const size_t tstep = 2 * hstep;
    const unsigned ldsw = (unsigned)wid * 1024u;
    const int aoff = lds_byte(wr * 64 + fr, fq * 8), boff = lds_byte(wc * 32 + fr, fq * 8);
#define PG8_SA(b, h) (((b) * 2 + (h)) * HTB)
#define PG8_SB(b, h) ((4 + (b) * 2 + (h)) * HTB)
#define PG8_STAGE(bufoff, gbase, voff) do { _Pragma("unroll") for (int _i = 0; _i < 2; ++_i) \
        __builtin_amdgcn_global_load_lds((const unsigned*)((const char*)(gbase) + (voff)[_i]), (PG8_LAS unsigned*)(lds + (bufoff) + ldsw + _i * 8192), 16, 0, 0); } while (0)
#define PG8_LDA(dst, b, h) do { _Pragma("unroll") for (int m = 0; m < 4; ++m) _Pragma("unroll") for (int k = 0; k < 2; ++k) dst[m][k] = *(const PG8_LAS bf16x8*)(lds + PG8_SA(b, h) + aoff + m * 2048 + k * 1024); } while (0)
#define PG8_LDB(dst, b, h) do { _Pragma("unroll") for (int n = 0; n < 2; ++n) _Pragma("unroll") for (int k = 0; k < 2; ++k) dst[n][k] = *(const PG8_LAS bf16x8*)(lds + PG8_SB(b, h) + boff + n * 2048 + k * 1024); } while (0)
#define PG8_MMA(ai, bj, At, Bt) do { __builtin_amdgcn_s_setprio(1); _Pragma("unroll") for (int m = 0; m < 4; ++m) _Pragma("unroll") for (int n = 0; n < 2; ++n) _Pragma("unroll") for (int k = 0; k < 2; ++k) \
        acc[ai][bj][m][n] = __builtin_amdgcn_mfma_f32_16x16x32_bf16(Bt[n][k], At[m][k], acc[ai][bj][m][n], 0, 0, 0); __builtin_amdgcn_s_setprio(0); } while (0)
#define PG8_WAIT_V(n) asm volatile("s_waitcnt vmcnt(" #n ")" ::: "memory")
#define PG8_WAIT_L(n) asm volatile("s_waitcnt lgkmcnt(" #n ")" ::: "memory")
#define PG8_BAR __builtin_amdgcn_s_barrier()
#define PG8_SCHED __builtin_amdgcn_sched_barrier(0)
    Unit cur, nxt; int ui = 0;
    if (!S.next(0, cur)) return;
    f32x4 acc[2][2][4][2];
#pragma unroll
    for (int a = 0; a < 2; ++a)
#pragma unroll
        for (int b = 0; b < 2; ++b)
#pragma unroll
            for (int m = 0; m < 4; ++m)
#pragma unroll
                for (int n = 0; n < 2; ++n) acc[a][b][m][n] = (f32x4){0.f, 0.f, 0.f, 0.f};
    bf16x8 At[4][2], B0[2][2], B1[2][2];
    const char* cA = (const char*)g.A + (size_t)cur.pm * tstep; const char* cB = (const char*)g.Bt + (size_t)cur.pn * tstep;
    S.a_ready(cur);
    if constexpr (SP2) {
        PG8_STAGE(PG8_SB(0, 0), cB, voffB); PG8_STAGE(PG8_SB(0, 1), cB + hstep, voffB); PG8_STAGE(PG8_SA(0, 0), cA, voffA); PG8_STAGE(PG8_SA(0, 1), cA + hstep, voffA);
        if (wr == 1) PG8_BAR;
        PG8_WAIT_V(2); PG8_BAR;
        PG8_STAGE(PG8_SB(1, 0), cB + kstep, voffB); PG8_STAGE(PG8_SA(1, 0), cA + kstep, voffA); PG8_STAGE(PG8_SB(1, 1), cB + hstep + kstep, voffB);
        PG8_WAIT_V(6); PG8_BAR;
    } else {
        PG8_STAGE(PG8_SB(0, 0), cB, voffB); PG8_STAGE(PG8_SA(0, 0), cA, voffA); PG8_STAGE(PG8_SB(0, 1), cB + hstep, voffB); PG8_STAGE(PG8_SA(0, 1), cA + hstep, voffA);
        if (wr == 1) PG8_BAR;
        PG8_WAIT_V(4); PG8_BAR;
        PG8_STAGE(PG8_SB(1, 0), cB + kstep, voffB); PG8_STAGE(PG8_SA(1, 0), cA + kstep, voffA); PG8_STAGE(PG8_SB(1, 1), cB + hstep + kstep, voffB);
        PG8_WAIT_V(6); PG8_BAR;
    }
    for (;;) {
        const bool has_next = S.next(ui + 1, nxt);
        const char* nA = has_next ? (const char*)g.A + (size_t)nxt.pm * tstep : cA; const char* nB = has_next ? (const char*)g.Bt + (size_t)nxt.pn * tstep : cB;
        for (int t = 0; t < nt; t += 2) {
            const bool last = (t == nt - 2);
            const char* a1 = cA + (size_t)(t + 1) * kstep;
            const char* a2 = last ? nA : cA + (size_t)(t + 2) * kstep; const char* b2 = last ? nB : cB + (size_t)(t + 2) * kstep;
            const char* a3 = a2 + kstep; const char* b3 = b2 + kstep;
            if (last && has_next) S.a_ready(nxt);
            if constexpr (SP2) {
            PG8_LDB(B0, 0, 0); PG8_LDB(B1, 0, 1); PG8_SCHED; PG8_LDA(At, 0, 0); PG8_STAGE(PG8_SA(1, 1), a1 + hstep, voffA);
            PG8_WAIT_V(8); PG8_WAIT_L(0); PG8_BAR; PG8_MMA(0, 0, At, B0); PG8_MMA(0, 1, At, B1); PG8_BAR; PG8_SCHED;
            PG8_LDA(At, 0, 1); PG8_STAGE(PG8_SB(0, 0), b2, voffB); PG8_STAGE(PG8_SB(0, 1), b2 + hstep, voffB); PG8_STAGE(PG8_SA(0, 0), a2, voffA);
            PG8_WAIT_V(8); PG8_WAIT_L(0); PG8_BAR; PG8_MMA(1, 0, At, B0); PG8_MMA(1, 1, At, B1); PG8_BAR; PG8_SCHED;
            PG8_LDB(B0, 1, 0); PG8_LDB(B1, 1, 1); PG8_SCHED; PG8_LDA(At, 1, 0); PG8_STAGE(PG8_SA(0, 1), a2 + hstep, voffA);
            PG8_WAIT_V(8); PG8_WAIT_L(0); PG8_BAR; PG8_MMA(0, 0, At, B0); PG8_MMA(0, 1, At, B1); PG8_BAR; PG8_SCHED;
            PG8_LDA(At, 1, 1); PG8_STAGE(PG8_SB(1, 0), b3, voffB); PG8_STAGE(PG8_SB(1, 1), b3 + hstep, voffB); PG8_STAGE(PG8_SA(1, 0), a3, voffA);
            PG8_WAIT_V(8); PG8_WAIT_L(0); PG8_BAR; PG8_MMA(1, 0, At, B0); PG8_MMA(1, 1, At, B1); PG8_BAR; PG8_SCHED;
            } else {
            PG8_LDB(B0, 0, 0); PG8_SCHED; PG8_LDA(At, 0, 0); PG8_STAGE(PG8_SA(1, 1), a1 + hstep, voffA);
            PG8_WAIT_L(8); PG8_BAR; PG8_WAIT_L(0); PG8_MMA(0, 0, At, B0); PG8_BAR; PG8_SCHED;
            PG8_LDB(B1, 0, 1); PG8_STAGE(PG8_SB(0, 0), b2, voffB);
            PG8_BAR; PG8_WAIT_L(0); PG8_MMA(0, 1, At, B1); PG8_BAR;
            PG8_LDA(At, 0, 1); PG8_STAGE(PG8_SA(0, 0), a2, voffA);
            PG8_BAR; PG8_WAIT_L(0); PG8_MMA(1, 0, At, B0); PG8_BAR; PG8_SCHED;
            PG8_STAGE(PG8_SB(0, 1), b2 + hstep, voffB);
            PG8_WAIT_V(6); PG8_BAR; PG8_MMA(1, 1, At, B1); PG8_BAR;
            PG8_LDB(B0, 1, 0); PG8_SCHED; PG8_LDA(At, 1, 0); PG8_STAGE(PG8_SA(0, 1), a2 + hstep, voffA);
            PG8_WAIT_L(8); PG8_BAR; PG8_WAIT_L(0); PG8_MMA(0, 0, At, B0); PG8_BAR; PG8_SCHED;
            PG8_LDB(B1, 1, 1); PG8_STAGE(PG8_SB(1, 0), b3, voffB);
            PG8_BAR; PG8_WAIT_L(0); PG8_MMA(0, 1, At, B1); PG8_BAR;
            PG8_LDA(At, 1, 1); PG8_STAGE(PG8_SA(1, 0), a3, voffA);
            PG8_BAR; PG8_WAIT_L(0); PG8_MMA(1, 0, At, B0); PG8_BAR; PG8_SCHED;
            PG8_STAGE(PG8_SB(1, 1), b3 + hstep, voffB);
            PG8_WAIT_V(6); PG8_BAR; PG8_MMA(1, 1, At, B1); PG8_BAR;
            }
        }
        if constexpr (ALIGN_EPI) { if (wr == 0) PG8_BAR; }
        if constexpr (!Epi::AFTER_DRAIN) { E(acc, cur, wr, wc, fr, fq); S.done(cur); }
        if (!has_next) break;
#pragma unroll
        for (int a = 0; a < 2; ++a)
#pragma unroll
            for (int b = 0; b < 2; ++b)
#pragma unroll
                for (int m = 0; m < 4; ++m)
#pragma unroll
                    for (int n = 0; n < 2; ++n) acc[a][b][m][n] = (f32x4){0.f, 0.f, 0.f, 0.f};
        cur = nxt; cA = nA; cB = nB; ++ui;
        if constexpr (ALIGN_EPI) { if (wr == 1) PG8_BAR; }
    }
    PG8_WAIT_V(0);
    if constexpr (!ALIGN_EPI) { if (wr == 0) PG8_BAR; }
    PG8_BAR;
    if constexpr (Epi::AFTER_DRAIN) { E.fused(acc, cur, wr, wc, fr, fq, lds, wid, lane); S.done(cur); }
#undef PG8_SA
#undef PG8_SB
#undef PG8_STAGE
#undef PG8_LDA
#undef PG8_LDB
#undef PG8_MMA
#undef PG8_WAIT_V
#undef PG8_WAIT_L
#undef PG8_BAR
#undef PG8_SCHED
}
}

constexpr int TOK = 8192, DM = 2048, SEQ = 2048, DFF = 5632, PROJW = 6144, MIXC = 6160, NMEM = 256;
constexpr float EPS = 1e-6f, LOG2E = 1.4426950408889634f;
constexpr float QSCALE = 0.08838834764831845f * LOG2E;
constexpr size_t MiB = 1u << 20;
constexpr size_t WS_WGU1 = 0, WS_WD1 = 44 * MiB, WS_WIN = 66 * MiB, WS_WOUT = 91 * MiB, WS_WQ = 99 * MiB, WS_WKV = 101 * MiB, WS_WO = 105 * MiB,
                 WS_WGU2 = 107 * MiB, WS_WD2 = 151 * MiB, WS_R1 = 173 * MiB  , WS_H = 269 * MiB  ,
                 WS_MIX = 301 * MiB, WS_DST = 333 * MiB, WS_MEMN = 365 * MiB, WS_KVX = 369 * MiB, WS_QX = 371 * MiB, WS_OX = 379 * MiB,
                 WS_SSQ = 387 * MiB, WS_GLR = 388 * MiB, WS_DECAY = 389 * MiB, WS_ROPE = 390 * MiB, WS_CTL = 392 * MiB  , WS_END = 393 * MiB;
constexpr size_t CTL_ZERO_BYTES = 16384;
constexpr int LDS_BYTES = 147456;
constexpr int NPHASE = 14;

#define LAS __attribute__((address_space(3)))
typedef unsigned short bf16;
typedef unsigned u32x4 __attribute__((ext_vector_type(4)));
typedef unsigned u32x2 __attribute__((ext_vector_type(2)));
typedef float f32x4 __attribute__((ext_vector_type(4)));
typedef short bf16x8 __attribute__((ext_vector_type(8)));
typedef short bf16x4 __attribute__((ext_vector_type(4)));
#define LDS_WAIT() asm volatile("s_waitcnt lgkmcnt(0)" ::: "memory")
__device__ __forceinline__ float bf2f(unsigned short h) { return __uint_as_float((unsigned)h << 16); }
__device__ __forceinline__ float bflo(unsigned w) { return __uint_as_float(w << 16); }
__device__ __forceinline__ float bfhi(unsigned w) { return __uint_as_float(w & 0xffff0000u); }
__device__ __forceinline__ unsigned pk2(float lo, float hi) { return pg8::cvt_pk_bf16(lo, hi); }
__device__ __forceinline__ unsigned short f2bf(float f) { return (unsigned short)(pg8::cvt_pk_bf16(f, 0.f) & 0xffffu); }
__device__ __forceinline__ float wave_sum(float v) {
#pragma unroll
    for (int o = 1; o < 64; o <<= 1) v += __shfl_xor(v, o);
    return v;
}
#define MMA16(X, Y, ACC) ACC = __builtin_amdgcn_mfma_f32_16x16x32_bf16((X), (Y), (ACC), 0, 0, 0)

__device__ __forceinline__ void* ldptr(LAS const unsigned long long* tab, int i) { const unsigned long long v = tab[i];
    const unsigned lo = __builtin_amdgcn_readfirstlane((unsigned)v), hi = __builtin_amdgcn_readfirstlane((unsigned)(v >> 32));
    return (void*)(__attribute__((address_space(1))) void*)(((unsigned long long)hi << 32) | lo); }
#define XB_TMO      128
#define XB_XCNT(j)  (256  + 64 * (j))
#define XB_XSUB(j)  (1280 + 64 * (j))
#define XB_XGEN(j)  (2304 + 64 * (j))
#define XB_TOP      3328
#define XB_TOPGEN   3392
#define XCD_BAR_WORDS 3456
#define XB_SPIN_CAP (1u << 18)

__device__ __forceinline__ unsigned xb_ld(unsigned* p)              { return __hip_atomic_load(p, __ATOMIC_RELAXED, __HIP_MEMORY_SCOPE_AGENT); }
__device__ __forceinline__ unsigned xb_add(unsigned* p, unsigned v) { return __hip_atomic_fetch_add(p, v, __ATOMIC_RELAXED, __HIP_MEMORY_SCOPE_AGENT); }
__device__ __forceinline__ unsigned xb_xcc_id() { return (unsigned)__builtin_amdgcn_s_getreg((3 << 11) | 20) & 0xFu; }
#define XB_SPIN(cond, bar) do { unsigned _sp = 0; while (cond) { __builtin_amdgcn_s_sleep(1); \
    if ((++_sp & 255u) == 0u) { if (xb_ld(&(bar)[XB_TMO])) break; if (_sp > XB_SPIN_CAP) { atomicAdd(&(bar)[XB_TMO], 1u); break; } } } } while (0)

struct XcdBarrier {
    unsigned* bar; unsigned x;
    volatile LAS unsigned* st;
};

__device__ __forceinline__ XcdBarrier xcd_barrier_post(unsigned* bar, volatile LAS unsigned* st) {
    XcdBarrier b; b.bar = bar; b.x = xb_xcc_id(); b.st = st;
    if (threadIdx.x == 0) (void)xb_add(&bar[XB_XCNT(b.x)], 1u);
    return b;
}
__device__ __forceinline__ void xcd_barrier_complete(unsigned* bar, unsigned x, unsigned& nloc, unsigned& nx) {
    const unsigned G = gridDim.x * gridDim.y * gridDim.z;
    unsigned sum, cnt, mine, sp = 0u;
    for (;;) {
        sum = 0u; cnt = 0u; mine = 0u;
#pragma unroll
        for (unsigned j = 0; j < 16; ++j) { const unsigned c = xb_ld(&bar[XB_XCNT(j)]); sum += c; cnt += (c > 0u) ? 1u : 0u; mine = (j == x) ? c : mine; }
        if (sum == G) break;
        __builtin_amdgcn_s_sleep(1);
        if ((++sp & 255u) == 0u) { if (xb_ld(&bar[XB_TMO])) break; if (sp > XB_SPIN_CAP) { atomicAdd(&bar[XB_TMO], 1u); break; } }
    }
    nloc = mine > 0u ? mine : 1u; nx = cnt > 0u ? cnt : 1u;
}

__device__ __forceinline__ void xcd_barrier(const XcdBarrier& b) {
    asm volatile("s_waitcnt vmcnt(0)" ::: "memory");
    __syncthreads();
    if (threadIdx.x == 0) {
        unsigned* bar = b.bar;
        __builtin_amdgcn_s_waitcnt(0);
        unsigned nloc = b.st[0], nx = b.st[1];
        if (nloc == 0u) { xcd_barrier_complete(bar, b.x, nloc, nx); b.st[0] = nloc; b.st[1] = nx; }
        const unsigned old = xb_add(&bar[XB_XSUB(b.x)], 1u);
        const unsigned gen = old / nloc;
        if (old + 1u == (gen + 1u) * nloc) {
            __builtin_amdgcn_fence(__ATOMIC_RELEASE, "agent");
            asm volatile("s_waitcnt vmcnt(0)" ::: "memory");
            const unsigned og = xb_add(&bar[XB_TOP], 1u);
            const unsigned tg = og / nx;
            if (og + 1u == (tg + 1u) * nx) xb_add(&bar[XB_TOPGEN], 1u);
            else XB_SPIN(xb_ld(&bar[XB_TOPGEN]) == tg, bar);
            __builtin_amdgcn_fence(__ATOMIC_ACQUIRE, "agent");
            xb_add(&bar[XB_XGEN(b.x)], 1u);
            asm volatile("s_waitcnt vmcnt(0)" ::: "memory");
        } else {
            XB_SPIN(xb_ld(&bar[XB_XGEN(b.x)]) == gen, bar);
            __builtin_amdgcn_fence(__ATOMIC_ACQUIRE, "agent");
            asm volatile("s_waitcnt vmcnt(0)" ::: "memory");
        }
    }
    __syncthreads();
}

struct Args { const float* in[26]; float* out; unsigned char* ws; int ph_lo, ph_hi; };

__device__ __forceinline__ void p0_tr(const float* __restrict__ W, int K, int N, bf16* WT, int rstride, int roff, LAS float* scr, int item, int lane, const float* gk = nullptr) {
    const int nblk = (N + 63) / 64, kb = item / nblk, nb = item % nblk, k0 = 64 * kb, n0 = 64 * nb;
    const int kq = lane >> 4, n4 = (lane & 15) * 4;
    const bool ok = (n0 + n4) < N;
    f32x4 v[16];
#pragma unroll
    for (int i = 0; i < 16; ++i) v[i] = ok ? __builtin_nontemporal_load((const f32x4*)(W + (size_t)(k0 + 4 * i + kq) * N + n0 + n4)) : (f32x4){0.f, 0.f, 0.f, 0.f};
#pragma unroll
    for (int i = 0; i < 16; ++i)
#pragma unroll
        for (int e = 0; e < 4; ++e) scr[(4 * i + kq) * 69 + n4 + e] = v[i][e];
    LDS_WAIT(); asm volatile("" ::: "memory");
    const int c = lane & 7;
    f32x4 ga = {1.f, 1.f, 1.f, 1.f}, gb = {1.f, 1.f, 1.f, 1.f};
    if (gk) { ga = *(const f32x4*)(gk + k0 + 8 * c); gb = *(const f32x4*)(gk + k0 + 8 * c + 4); }
#pragma unroll
    for (int j = 0; j < 8; ++j) { const int n = (lane >> 3) + 8 * j, gn = n0 + n; const LAS float* sp = scr + (8 * c) * 69 + n;
        u32x4 o; o.x = pk2(sp[0 * 69] * ga[0], sp[1 * 69] * ga[1]); o.y = pk2(sp[2 * 69] * ga[2], sp[3 * 69] * ga[3]); o.z = pk2(sp[4 * 69] * gb[0], sp[5 * 69] * gb[1]); o.w = pk2(sp[6 * 69] * gb[2], sp[7 * 69] * gb[3]);
        if (gn < N) { const int dr = (gn >> 7) * rstride + roff + (gn & 127); *(u32x4*)(WT + (size_t)dr * K + k0 + 8 * c) = o; } }
    LDS_WAIT(); asm volatile("" ::: "memory");
}

constexpr int QP = 144, VP = 72;
constexpr int VPA = 80;
constexpr int AT_QS = 0, AT_KS = 128 * QP * 2, AT_VT = AT_KS + 2 * 64 * QP * 2, AT_NB3 = 64 * QP * 2 + 128 * VPA * 2  , AT_BT = 3 * AT_NB3, AT_END = AT_BT + 2176 * 4;
__device__ __forceinline__ int vperm(int key) { return (key & 32) + 8 * ((key & 15) >> 2) + 4 * ((key >> 4) & 1) + (key & 3); }
struct KVRegs { u32x4 ka, kb, va, vb; };
__device__ __forceinline__ void attn_build_bias(LAS unsigned char* lds, int tid, float bref) {
    LAS float* BT = (LAS float*)(lds + AT_BT);
    for (int j = tid; j < 2176; j += 512) { const int d = 2047 - j;
        int c = ((d & 15) == 0) ? 1 : 0; c += (((d & 3) == 0) && d <= 512) ? 1 : 0; c += (d <= 128) ? 1 : 0;
        BT[j] = (d < 0 || c == 0) ? -INFINITY : ((c == 1) ? 0.f : ((c == 2) ? 1.f : 1.5849625007211562f)) - bref; }
}
__device__ __forceinline__ float attn_logit_bound(const float* gq, const float* gk, int lane, float extra) {
    float a = fmaxf(fabsf(gq[lane]), fabsf(gq[lane + 64])), b = fmaxf(fabsf(gk[lane]), fabsf(gk[lane + 64]));
#pragma unroll
    for (int o = 1; o < 64; o <<= 1) { a = fmaxf(a, __shfl_xor(a, o)); b = fmaxf(b, __shfl_xor(b, o)); }
    return fminf(128.0f * a * b * QSCALE * 1.02f + 0.5f + extra, 60.0f);
}
template <int MODE>
__device__ __forceinline__ void attn_item(LAS unsigned char* lds, const bf16* Qp, int ldq, const bf16* Kp, const bf16* Vp, int ldkv, int ntiles  , int q0,
                                          bf16* Op, int ldo, const float* qg, const float* kg, const bf16* Bq = nullptr, const float* ssq = nullptr, int grow0 = 0, float bref = 0.f) {
    const int tid = tid_now(), lane = tid & 63, w = tid >> 6, fr = lane & 15, fq = lane >> 4;
    LAS bf16* Qs = (LAS bf16*)(lds + (MODE == 0 ? 2 * AT_NB3 : AT_QS)); const LAS float* BT = (const LAS float*)(lds + AT_BT);
    auto koff = [&](int b) { return MODE == 0 ? b * AT_NB3 : AT_KS + b * (64 * QP * 2); };
    auto voff = [&](int b) { return MODE == 0 ? b * AT_NB3 + 64 * QP * 2 : AT_VT + b * (128 * VPA * 2); };
    const int kr = tid >> 3, kj = tid & 7;
    const int vr = tid & 63, vj = tid >> 6;
    auto norm16 = [&](u32x4& a, u32x4& b, const float* gn, float extra) {
        float x[16];
#pragma unroll
        for (int e = 0; e < 4; ++e) { x[2 * e] = bflo(a[e]); x[2 * e + 1] = bfhi(a[e]); x[8 + 2 * e] = bflo(b[e]); x[9 + 2 * e] = bfhi(b[e]); }
        float sq = 0.f;
#pragma unroll
        for (int e = 0; e < 16; ++e) sq += x[e] * x[e];
        sq += __shfl_xor(sq, 1); sq += __shfl_xor(sq, 2); sq += __shfl_xor(sq, 4);
        const float rs = __builtin_amdgcn_rsqf(sq * (1.f / 128.f) + EPS) * extra;
        const f32x4 g0 = *(const f32x4*)(gn + 8 * kj), g1 = *(const f32x4*)(gn + 8 * kj + 4), g2 = *(const f32x4*)(gn + 64 + 8 * kj), g3 = *(const f32x4*)(gn + 64 + 8 * kj + 4);
        a[0] = pk2(x[0] * rs * g0[0], x[1] * rs * g0[1]); a[1] = pk2(x[2] * rs * g0[2], x[3] * rs * g0[3]); a[2] = pk2(x[4] * rs * g1[0], x[5] * rs * g1[1]); a[3] = pk2(x[6] * rs * g1[2], x[7] * rs * g1[3]);
        b[0] = pk2(x[8] * rs * g2[0], x[9] * rs * g2[1]); b[1] = pk2(x[10] * rs * g2[2], x[11] * rs * g2[3]); b[2] = pk2(x[12] * rs * g3[0], x[13] * rs * g3[1]); b[3] = pk2(x[14] * rs * g3[2], x[15] * rs * g3[3]);
    };
    auto load_tile = [&](KVRegs& r, int t) {
        const bf16* ks = Kp + (size_t)(t * 64 + kr) * ldkv; r.ka = *(const u32x4*)(ks + 8 * kj); r.kb = *(const u32x4*)(ks + 64 + 8 * kj);
        if (MODE == 0) { const bf16* vs = Vp + (size_t)(tid >> 2) * SEQ + t * 64 + 16 * (tid & 3); r.va = *(const u32x4*)vs; r.vb = *(const u32x4*)(vs + 8); }
        else { const bf16* vs = Vp + (size_t)(t * 64 + vr) * ldkv; r.va = *(const u32x4*)(vs + 8 * vj); r.vb = *(const u32x4*)(vs + 64 + 8 * vj); } };
    auto stage = [&](KVRegs& r, int buf) {
        LAS bf16* Ks = (LAS bf16*)(lds + koff(buf)); LAS bf16* VT = (LAS bf16*)(lds + voff(buf));
        if (MODE >= 1) norm16(r.ka, r.kb, kg, 1.0f);
        *(LAS u32x4*)(Ks + kr * QP + 8 * kj) = r.ka; *(LAS u32x4*)(Ks + kr * QP + 64 + 8 * kj) = r.kb;
        if (MODE == 0) { *(LAS u32x4*)(VT + (tid >> 2) * VPA + 16 * (tid & 3)) = r.va; *(LAS u32x4*)(VT + (tid >> 2) * VPA + 16 * (tid & 3) + 8) = r.vb; }
        else
#pragma unroll
        for (int e = 0; e < 4; ++e) { const int pv = vperm(vr);
                                      VT[(8 * vj + 2 * e) * VPA + pv] = (bf16)(r.va[e] & 0xffffu); VT[(8 * vj + 2 * e + 1) * VPA + pv] = (bf16)(r.va[e] >> 16);
                                      VT[(64 + 8 * vj + 2 * e) * VPA + pv] = (bf16)(r.vb[e] & 0xffffu); VT[(64 + 8 * vj + 2 * e + 1) * VPA + pv] = (bf16)(r.vb[e] >> 16); } };
    KVRegs r0, r1;
    load_tile(r0, 0); load_tile(r1, 1);
    if (MODE == 2) {
        constexpr int GP = 80, GBUF = 128 * GP * 2;
        const int lr = tid >> 2, lc = (tid & 3) * 16;
        const bf16* ap = Qp + (size_t)lr * ldq + lc; const bf16* bp = Bq + (size_t)lr * 2048 + lc;
        u32x4 ra[4][4];
#define QG_LD(j, step) do { const int ko_ = (step) * 64; ra[j][0] = *(const u32x4*)(ap + ko_); ra[j][1] = *(const u32x4*)(ap + ko_ + 8); ra[j][2] = *(const u32x4*)(bp + ko_); ra[j][3] = *(const u32x4*)(bp + ko_ + 8); } while (0)
#define QG_ST(j, buf) do { LAS bf16* As_ = (LAS bf16*)(lds + AT_KS + (buf) * 2 * GBUF); LAS bf16* Bs_ = As_ + 128 * GP; \
        *(LAS u32x4*)(As_ + lr * GP + lc) = ra[j][0]; *(LAS u32x4*)(As_ + lr * GP + lc + 8) = ra[j][1]; *(LAS u32x4*)(Bs_ + lr * GP + lc) = ra[j][2]; *(LAS u32x4*)(Bs_ + lr * GP + lc + 8) = ra[j][3]; } while (0)
        QG_LD(0, 0); QG_LD(1, 1); QG_LD(2, 2); QG_LD(3, 3);
        QG_ST(0, 0); QG_LD(0, 4);
        __syncthreads();
        f32x4 acc[8];
#pragma unroll
        for (int i = 0; i < 8; ++i) acc[i] = (f32x4){0.f, 0.f, 0.f, 0.f};
#pragma unroll 1
        for (int st4 = 0; st4 < 32; st4 += 4) {
#pragma unroll
            for (int u = 0; u < 4; ++u) { const int st = st4 + u, cb = u & 1, j = (u + 1) & 3;
                if (st + 1 < 32) QG_ST(j, cb ^ 1);
                if (st + 5 < 32) QG_LD(j, st + 5);
                const LAS bf16* As = (const LAS bf16*)(lds + AT_KS + cb * 2 * GBUF); const LAS bf16* Bs = As + 128 * GP;
                bf16x8 af[2], bfr[8][2];
#pragma unroll
                for (int ks = 0; ks < 2; ++ks) { af[ks] = *(const LAS bf16x8*)(As + (16 * w + fr) * GP + 32 * ks + 8 * fq);
#pragma unroll
                    for (int nb = 0; nb < 8; ++nb) bfr[nb][ks] = *(const LAS bf16x8*)(Bs + (16 * nb + fr) * GP + 32 * ks + 8 * fq); }
#pragma unroll
                for (int ks = 0; ks < 2; ++ks)
#pragma unroll
                    for (int nb = 0; nb < 8; ++nb) MMA16(bfr[nb][ks], af[ks], acc[nb]);
                __builtin_amdgcn_sched_group_barrier(0x100, 10, 0);
#pragma unroll
                for (int g = 0; g < 8; ++g) { __builtin_amdgcn_sched_group_barrier(0x008, 1, 0); __builtin_amdgcn_sched_group_barrier(0x100, 1, 0); }
                __builtin_amdgcn_sched_group_barrier(0x008, 8, 0);
                __builtin_amdgcn_sched_barrier(0);
                __syncthreads(); }
        }
#undef QG_LD
#undef QG_ST
        const float rs = pg8::row_rs(ssq, grow0 + 16 * w + fr, fq);
        float sq = 0.f;
#pragma unroll
        for (int nb = 0; nb < 8; ++nb) { acc[nb] = acc[nb] * rs; sq += (acc[nb][0] * acc[nb][0] + acc[nb][1] * acc[nb][1]) + (acc[nb][2] * acc[nb][2] + acc[nb][3] * acc[nb][3]); }
        sq += __shfl_xor(sq, 16); sq += __shfl_xor(sq, 32);
        const float rn = __builtin_amdgcn_rsqf(sq * (1.f / 128.f) + EPS) * QSCALE;
#pragma unroll
        for (int nb = 0; nb < 8; ++nb) { const f32x4 gv = *(const f32x4*)(qg + 16 * nb + 4 * fq);
            u32x2 ov; ov.x = pk2(acc[nb][0] * rn * gv[0], acc[nb][1] * rn * gv[1]); ov.y = pk2(acc[nb][2] * rn * gv[2], acc[nb][3] * rn * gv[3]);
            *(LAS u32x2*)(Qs + (16 * w + fr) * QP + 16 * nb + 4 * fq) = ov; }
        __syncthreads();
    } else {
#pragma unroll
    for (int p = 0; p < 2; ++p) {
        const bf16* src = Qp + (size_t)(p * 64 + kr) * ldq;
        u32x4 a = *(const u32x4*)(src + 8 * kj), b = *(const u32x4*)(src + 64 + 8 * kj);
        if (MODE == 1) norm16(a, b, qg, QSCALE);
        *(LAS u32x4*)(Qs + (p * 64 + kr) * QP + 8 * kj) = a; *(LAS u32x4*)(Qs + (p * 64 + kr) * QP + 64 + 8 * kj) = b;
    }
    }
    stage(r0, 0); if (2 < ntiles) load_tile(r0, 2);
    if (MODE == 0) { stage(r1, 1); if (3 < ntiles) load_tile(r1, 3); }
    __syncthreads();
    const int rp = w >> 1, kh = w & 1;
    bf16x8 qf[2][4];
#pragma unroll
    for (int rb = 0; rb < 2; ++rb)
#pragma unroll
        for (int ks = 0; ks < 4; ++ks) qf[rb][ks] = *(const LAS bf16x8*)(Qs + (32 * rp + 16 * rb + fr) * QP + 32 * ks + 8 * fq);
    f32x4 o[2][8];
#pragma unroll
    for (int rb = 0; rb < 2; ++rb)
#pragma unroll
        for (int i = 0; i < 8; ++i) o[rb][i] = (f32x4){0.f, 0.f, 0.f, 0.f};
    float lrun[2] = {0.f, 0.f};
    auto compute = [&](int buf, int t) {
        const LAS bf16* Ks = (const LAS bf16*)(lds + koff(buf)); const LAS bf16* VT = (const LAS bf16*)(lds + voff(buf));
        bf16x8 kf[2][4]; float bias[2][2][4];
#pragma unroll
        for (int kb = 0; kb < 2; ++kb)
#pragma unroll
            for (int ks = 0; ks < 4; ++ks) kf[kb][ks] = *(const LAS bf16x8*)(Ks + (32 * kh + 16 * kb + fr) * QP + 32 * ks + 8 * fq);
        if (MODE == 0) { const LAS float* bp = BT + (2047 - 16 - (q0 + 32 * rp + fr - t * 64 - 32 * kh - 4 * fq));
#pragma unroll
                for (int kb = 0; kb < 2; ++kb)
#pragma unroll
                    for (int i = 0; i < 4; ++i) bias[0][kb][i] = bp[16 * (kb + 1) + i]; }
        __builtin_amdgcn_sched_barrier(0);
        f32x4 s[2][2];
#pragma unroll
        for (int rb = 0; rb < 2; ++rb)
#pragma unroll
            for (int kb = 0; kb < 2; ++kb) s[rb][kb] = (f32x4){0.f, 0.f, 0.f, 0.f};
        bf16x8 pf[2];
        auto smax = [&](int rb) {
            if (MODE == 0) { s[rb][0] = s[rb][0] + (f32x4){bias[rb][0][0], bias[rb][0][1], bias[rb][0][2], bias[rb][0][3]}; s[rb][1] = s[rb][1] + (f32x4){bias[rb][1][0], bias[rb][1][1], bias[rb][1][2], bias[rb][1][3]}; }
            else { s[rb][0] = s[rb][0] - bref; s[rb][1] = s[rb][1] - bref; }
            float ps = 0.f;
#pragma unroll
            for (int kb = 0; kb < 2; ++kb)
#pragma unroll
                for (int i = 0; i < 4; ++i) { s[rb][kb][i] = __builtin_amdgcn_exp2f(s[rb][kb][i]); ps += s[rb][kb][i]; }
            lrun[rb] += ps;
            u32x4 pw; pw.x = pk2(s[rb][0][0], s[rb][0][1]); pw.y = pk2(s[rb][0][2], s[rb][0][3]); pw.z = pk2(s[rb][1][0], s[rb][1][1]); pw.w = pk2(s[rb][1][2], s[rb][1][3]);
            pf[rb] = __builtin_bit_cast(bf16x8, pw); };
#pragma unroll
        for (int ks = 0; ks < 4; ++ks)
#pragma unroll
            for (int kb = 0; kb < 2; ++kb) MMA16(kf[kb][ks], qf[0][ks], s[0][kb]);
        __builtin_amdgcn_sched_barrier(0);
        bf16x8 vf[8];
#pragma unroll
        for (int db = 0; db < 8; ++db) vf[db] = *(const LAS bf16x8*)(VT + (16 * db + fr) * VPA + 32 * kh + 8 * fq);
        if (MODE == 0) { const LAS float* bp = BT + (2047 - 16 - (q0 + 32 * rp + fr - t * 64 - 32 * kh - 4 * fq));
#pragma unroll
            for (int kb = 0; kb < 2; ++kb)
#pragma unroll
                for (int i = 0; i < 4; ++i) bias[1][kb][i] = bp[16 * kb + i]; }
#pragma unroll
        for (int ks = 0; ks < 4; ++ks)
#pragma unroll
            for (int kb = 0; kb < 2; ++kb) MMA16(kf[kb][ks], qf[1][ks], s[1][kb]);
        smax(0);
#pragma unroll
        for (int g = 0; g < 8; ++g) { __builtin_amdgcn_sched_group_barrier(0x008, 1, 0); __builtin_amdgcn_sched_group_barrier(0x100, 1, 0); __builtin_amdgcn_sched_group_barrier(0x002, 4, 0); }
        __builtin_amdgcn_sched_barrier(0);
#pragma unroll
        for (int db = 0; db < 8; ++db) MMA16(vf[db], pf[0], o[0][db]);
        smax(1);
#pragma unroll
        for (int g = 0; g < 8; ++g) { __builtin_amdgcn_sched_group_barrier(0x008, 1, 1); __builtin_amdgcn_sched_group_barrier(0x002, 4, 1); }
        __builtin_amdgcn_sched_barrier(0);
#pragma unroll
        for (int db = 0; db < 8; ++db) MMA16(vf[db], pf[1], o[1][db]);
        __builtin_amdgcn_sched_barrier(0);
    };
    if (MODE == 0) {
        __syncthreads();
        int cur = 0;
        for (int t = 0; t < ntiles; t += 2) {
            int b2 = cur + 2; if (b2 >= 3) b2 -= 3;
            if (t + 2 < ntiles) { stage(r0, b2); if (t + 4 < ntiles) load_tile(r0, t + 4); }
            compute(cur, t);
            __syncthreads();
            int b1 = cur + 1; if (b1 >= 3) b1 -= 3;
            if (t + 3 < ntiles) { stage(r1, cur); if (t + 5 < ntiles) load_tile(r1, t + 5); }
            compute(b1, t + 1);
            __syncthreads();
            cur = b2;
        }
    } else {
    for (int t = 0; t < ntiles; t += 2) {
        stage(r1, 1); if (t + 3 < ntiles) load_tile(r1, t + 3);
        compute(0, t);
        __syncthreads();
        if (t + 2 < ntiles) { stage(r0, 0); if (t + 4 < ntiles) load_tile(r0, t + 4); }
        compute(1, t + 1);
        __syncthreads();
    }
    }
    LAS float* X = (LAS float*)(lds + (MODE == 0 ? 0 : AT_KS));
    if (kh == 1) {
#pragma unroll
        for (int rb = 0; rb < 2; ++rb) {
#pragma unroll
            for (int db = 0; db < 8; ++db)
#pragma unroll
                for (int i = 0; i < 4; ++i) X[(rp * 68 + rb * 32 + db * 4 + i) * 64 + lane] = o[rb][db][i];
            X[(rp * 68 + 66 + rb) * 64 + lane] = lrun[rb]; }
    }
    __syncthreads();
    if (kh == 0) {
#pragma unroll
        for (int rb = 0; rb < 2; ++rb) {
            float l = lrun[rb] + X[(rp * 68 + 66 + rb) * 64 + lane]; l += __shfl_xor(l, 16); l += __shfl_xor(l, 32);
            const float inv = 1.0f / l;
            bf16* orow = Op + (size_t)(32 * rp + 16 * rb + fr) * ldo + 4 * fq;
#pragma unroll
            for (int db = 0; db < 8; ++db) { float v[4];
#pragma unroll
                for (int i = 0; i < 4; ++i) v[i] = (o[rb][db][i] + X[(rp * 68 + rb * 32 + db * 4 + i) * 64 + lane]) * inv;
                u32x2 ov; ov.x = pk2(v[0], v[1]); ov.y = pk2(v[2], v[3]); *(u32x2*)(orow + 16 * db) = ov; }
        }
    }
    __syncthreads();
}

__device__ __forceinline__ void gla_logdecay(float (&b)[16], float& blast, const LAS float* glrs, const float (&wcol)[16], const float bias, int d, int g, LAS float* tot) {
    float run = 0.f;
#pragma unroll
    for (int ii = 0; ii < 16; ++ii) { const LAS f32x4* gr = (const LAS f32x4*)(glrs + (16 * g + ii) * 16); float z = bias;
#pragma unroll
        for (int r4 = 0; r4 < 4; ++r4) { const f32x4 gv = gr[r4]; z += gv[0] * wcol[4 * r4] + gv[1] * wcol[4 * r4 + 1] + gv[2] * wcol[4 * r4 + 2] + gv[3] * wcol[4 * r4 + 3]; }
        const float la = -(fmaxf(-z, 0.f) + __logf(1.0f + __expf(-fabsf(z)))) * (1.0f / 16.0f);
        run += la; b[ii] = run; }
    tot[g * 128 + d] = run;
    __syncthreads();
    float off = 0.f, all = 0.f;
#pragma unroll
    for (int gg = 0; gg < 4; ++gg) { const float tv = tot[gg * 128 + d]; all += tv; if (gg < g) off += tv; }
#pragma unroll
    for (int ii = 0; ii < 16; ++ii) b[ii] += off;
    blast = all;
}
constexpr int GL_QE = 0, GL_KE = 64 * QP * 2, GL_VT = GL_KE + 64 * QP * 2, GL_AS = GL_VT + 256 * VP * 2, GL_TOT = GL_AS + 64 * VP * 2, GL_RED = GL_TOT + 2048, GL_GLR = GL_RED + 2048, GL_END = GL_GLR + 4096;
constexpr int GA_KDT = 0, GA_KRAW = 128 * VP * 2, GA_VT = GA_KRAW + 64 * QP * 2, GA_TOT = GA_VT + 256 * VP * 2, GA_GLR = GA_TOT + 2048, GA_END = GA_GLR + 4096;
__device__ __forceinline__ void gla_stage_glr(LAS float* glrs, const float* glr, int R0, int tid) { if (tid < 256) *(LAS f32x4*)(glrs + tid * 4) = *(const f32x4*)(glr + (size_t)R0 * 16 + tid * 4); }
__device__ __forceinline__ void gla_stage_raw(LAS bf16* dst, const bf16* src, int ld, int tid) { const int r = tid >> 3, j = tid & 7; const bf16* p = src + (size_t)r * ld;
    *(LAS u32x4*)(dst + r * QP + 8 * j) = *(const u32x4*)(p + 8 * j); *(LAS u32x4*)(dst + r * QP + 64 + 8 * j) = *(const u32x4*)(p + 64 + 8 * j); }
__device__ __forceinline__ void gla_load_vt(LAS bf16* VT, const bf16* vsrc  ) {
    const int tid = tid_now(), e = tid >> 1, hf = tid & 1;
    const bf16* p = vsrc + (size_t)e * SEQ + 32 * hf;
#pragma unroll
    for (int q = 0; q < 4; ++q) *(LAS u32x4*)(VT + e * VP + 32 * hf + 8 * q) = *(const u32x4*)(p + 8 * q);
}
__device__ __forceinline__ void gla_stepA(LAS unsigned char* lds, int item, const bf16* proj, const bf16* vtg, const float* glr, const float* W2, const float* b2, bf16* dST, float* decay) {
    const int tid = tid_now(), lane = tid & 63, w = tid >> 6, fr = lane & 15, fq = lane >> 4;
    const int bb = item >> 7, hg = (item >> 5) & 3, n = item & 31, R0 = bb * SEQ + n * 64;
    LAS bf16* KDT = (LAS bf16*)(lds + GA_KDT);
    LAS bf16* KR = (LAS bf16*)(lds + GA_KRAW); LAS float* glrs = (LAS float*)(lds + GA_GLR);
    LAS bf16* VT = (LAS bf16*)(lds + GA_VT); LAS float* tot = (LAS float*)(lds + GA_TOT);
    const int d = tid & 127, g = tid >> 7;
    float wcol[16];
#pragma unroll
    for (int r = 0; r < 16; ++r) wcol[r] = W2[r * 512 + hg * 128 + d];
    const float wbias = b2[hg * 128 + d];
    gla_stage_glr(glrs, glr, R0, tid);
    gla_stage_raw(KR, proj + (size_t)R0 * PROJW + 3584 + hg * 128, PROJW, tid);
    gla_load_vt(VT, vtg + (size_t)(bb * 4 + hg) * 256 * SEQ + n * 64);
    __syncthreads();
    float b[16], blast;
    gla_logdecay(b, blast, glrs, wcol, wbias, d, g, tot);
    if (g == 0) decay[(size_t)item * 128 + d] = __expf(blast);
    { float kd[16];
#pragma unroll
      for (int ii = 0; ii < 16; ++ii) kd[ii] = bf2f(KR[(16 * g + ii) * QP + d]) * __expf(blast - b[ii]);
      u32x4 p0, p1; p0.x = pk2(kd[0], kd[1]); p0.y = pk2(kd[2], kd[3]); p0.z = pk2(kd[4], kd[5]); p0.w = pk2(kd[6], kd[7]);
      p1.x = pk2(kd[8], kd[9]); p1.y = pk2(kd[10], kd[11]); p1.z = pk2(kd[12], kd[13]); p1.w = pk2(kd[14], kd[15]);
      *(LAS u32x4*)(KDT + d * VP + 16 * g) = p0; *(LAS u32x4*)(KDT + d * VP + 16 * g + 8) = p1; }
    __syncthreads();
    f32x4 acc[2][8];
#pragma unroll
    for (int eb = 0; eb < 2; ++eb)
#pragma unroll
        for (int db = 0; db < 8; ++db) acc[eb][db] = (f32x4){0.f, 0.f, 0.f, 0.f};
#pragma unroll
    for (int ks = 0; ks < 2; ++ks) { bf16x8 vf[2];
#pragma unroll
        for (int eb = 0; eb < 2; ++eb) vf[eb] = *(const LAS bf16x8*)(VT + (32 * w + 16 * eb + fr) * VP + 32 * ks + 8 * fq);
#pragma unroll
        for (int db = 0; db < 8; ++db) { const bf16x8 kf = *(const LAS bf16x8*)(KDT + (16 * db + fr) * VP + 32 * ks + 8 * fq);
#pragma unroll
            for (int eb = 0; eb < 2; ++eb) MMA16(kf, vf[eb], acc[eb][db]); } }
    bf16* dst = dST + (size_t)item * 32768;
#pragma unroll
    for (int eb = 0; eb < 2; ++eb)
#pragma unroll
        for (int db = 0; db < 8; ++db) { u32x2 ov; ov.x = pk2(acc[eb][db][0], acc[eb][db][1]); ov.y = pk2(acc[eb][db][2], acc[eb][db][3]);
            *(u32x2*)(dst + (size_t)(32 * w + 16 * eb + fr) * 128 + 16 * db + 4 * fq) = ov; }
    __syncthreads();
}
__device__ __forceinline__ void gla_stepC(LAS unsigned char* lds, int item, const bf16* proj, const bf16* vtg, const float* glr, const float* W2, const float* b2, const bf16* sT, const float* gout, bf16* mix) {
    const int tid = tid_now(), lane = tid & 63, w = tid >> 6, fr = lane & 15, fq = lane >> 4;
    const int bb = item >> 7, hg = (item >> 5) & 3, n = item & 31, R0 = bb * SEQ + n * 64;
    LAS bf16* QE = (LAS bf16*)(lds + GL_QE); LAS bf16* KE = (LAS bf16*)(lds + GL_KE); LAS bf16* VT = (LAS bf16*)(lds + GL_VT); LAS bf16* AS = (LAS bf16*)(lds + GL_AS);
    LAS float* tot = (LAS float*)(lds + GL_TOT); LAS float* red = (LAS float*)(lds + GL_RED); LAS float* glrs = (LAS float*)(lds + GL_GLR);
    const int d = tid & 127, g = tid >> 7;
    float wcol[16];
#pragma unroll
    for (int r = 0; r < 16; ++r) wcol[r] = W2[r * 512 + hg * 128 + d];
    const float wbias = b2[hg * 128 + d];
    const bf16* sp = sT + (size_t)item * 32768;
    bf16x8 sfr[4][2];
#pragma unroll
    for (int ks = 0; ks < 4; ++ks)
#pragma unroll
        for (int eb = 0; eb < 2; ++eb) sfr[ks][eb] = *(const bf16x8*)(sp + (size_t)(32 * w + 16 * eb + fr) * 128 + 32 * ks + 8 * fq);
    u32x2 rgv[4][2]; f32x4 gnv[2];
#pragma unroll
    for (int eb = 0; eb < 2; ++eb) { gnv[eb] = *(const f32x4*)(gout + 32 * w + 16 * eb + 4 * fq);
#pragma unroll
        for (int ib = 0; ib < 4; ++ib) rgv[ib][eb] = *(const u32x2*)(proj + (size_t)(R0 + 16 * ib + fr) * PROJW + 5120 + hg * 256 + 32 * w + 16 * eb + 4 * fq); }
    gla_stage_glr(glrs, glr, R0, tid);
    gla_stage_raw(QE, proj + (size_t)R0 * PROJW + 3072 + hg * 128, PROJW, tid);
    gla_stage_raw(KE, proj + (size_t)R0 * PROJW + 3584 + hg * 128, PROJW, tid);
    gla_load_vt(VT, vtg + (size_t)(bb * 4 + hg) * 256 * SEQ + n * 64);
    __syncthreads();
    float b[16], blast;
    gla_logdecay(b, blast, glrs, wcol, wbias, d, g, tot);
    {
#pragma unroll
      for (int ii = 0; ii < 16; ++ii) { const float eb = __expf(b[ii]); const int o_ = (16 * g + ii) * QP + d;
          QE[o_] = f2bf(bf2f(QE[o_]) * 0.08838834764831845f * eb);
          KE[o_] = f2bf(bf2f(KE[o_]) * __builtin_amdgcn_rcpf(eb)); } }
    __syncthreads();
    { const int ib = w >> 1;
#pragma unroll
      for (int jj = 0; jj < 2; ++jj) { const int jb = 2 * (w & 1) + jj; f32x4 a = (f32x4){0.f, 0.f, 0.f, 0.f};
#pragma unroll
          for (int ks = 0; ks < 4; ++ks) { const bf16x8 kf = *(const LAS bf16x8*)(KE + (16 * jb + fr) * QP + 32 * ks + 8 * fq); const bf16x8 qf = *(const LAS bf16x8*)(QE + (16 * ib + fr) * QP + 32 * ks + 8 * fq); MMA16(kf, qf, a); }
          const int i = 16 * ib + fr, j0 = 16 * jb + 4 * fq;
          u32x2 ov; ov.x = pk2(j0 <= i ? a[0] : 0.f, j0 + 1 <= i ? a[1] : 0.f); ov.y = pk2(j0 + 2 <= i ? a[2] : 0.f, j0 + 3 <= i ? a[3] : 0.f);
          *(LAS u32x2*)(AS + i * VP + j0) = ov; } }
    __syncthreads();
    f32x4 acc[2][4];
#pragma unroll
    for (int eb = 0; eb < 2; ++eb)
#pragma unroll
        for (int ib = 0; ib < 4; ++ib) acc[eb][ib] = (f32x4){0.f, 0.f, 0.f, 0.f};
#pragma unroll
    for (int ks = 0; ks < 2; ++ks) { bf16x8 vf[2];
#pragma unroll
        for (int eb = 0; eb < 2; ++eb) vf[eb] = *(const LAS bf16x8*)(VT + (32 * w + 16 * eb + fr) * VP + 32 * ks + 8 * fq);
#pragma unroll
        for (int ib = 0; ib < 4; ++ib) { const bf16x8 af = *(const LAS bf16x8*)(AS + (16 * ib + fr) * VP + 32 * ks + 8 * fq);
#pragma unroll
            for (int eb = 0; eb < 2; ++eb) MMA16(vf[eb], af, acc[eb][ib]); } }
#pragma unroll
    for (int ks = 0; ks < 4; ++ks) {
#pragma unroll
        for (int ib = 0; ib < 4; ++ib) { const bf16x8 qf = *(const LAS bf16x8*)(QE + (16 * ib + fr) * QP + 32 * ks + 8 * fq);
#pragma unroll
            for (int eb = 0; eb < 2; ++eb) MMA16(sfr[ks][eb], qf, acc[eb][ib]); } }
#pragma unroll
    for (int ib = 0; ib < 4; ++ib) { float q = 0.f;
#pragma unroll
        for (int eb = 0; eb < 2; ++eb) q += (acc[eb][ib][0] * acc[eb][ib][0] + acc[eb][ib][1] * acc[eb][ib][1]) + (acc[eb][ib][2] * acc[eb][ib][2] + acc[eb][ib][3] * acc[eb][ib][3]);
        q += __shfl_xor(q, 16); q += __shfl_xor(q, 32);
        if (fq == 0) red[w * 64 + 16 * ib + fr] = q; }
    __syncthreads();
#pragma unroll
    for (int ib = 0; ib < 4; ++ib) { float q = 0.f;
#pragma unroll
        for (int ww = 0; ww < 8; ++ww) q += red[ww * 64 + 16 * ib + fr];
        const float rs = __builtin_amdgcn_rsqf(q * (1.f / 256.f) + EPS);
        const size_t row = (size_t)(R0 + 16 * ib + fr);
#pragma unroll
        for (int eb = 0; eb < 2; ++eb) { const int e = 32 * w + 16 * eb + 4 * fq;
            const u32x2 rg = rgv[ib][eb]; const f32x4 gn = gnv[eb];
            const float r0 = bflo(rg.x), r1 = bfhi(rg.x), r2 = bflo(rg.y), r3 = bfhi(rg.y);
            u32x2 ov; ov.x = pk2(acc[eb][ib][0] * rs * gn[0] * pg8::silu_f(r0), acc[eb][ib][1] * rs * gn[1] * pg8::silu_f(r1));
            ov.y = pk2(acc[eb][ib][2] * rs * gn[2] * pg8::silu_f(r2), acc[eb][ib][3] * rs * gn[3] * pg8::silu_f(r3));
            *(u32x2*)(mix + row * DM + 1024 + hg * 256 + e) = ov; } }
    __syncthreads();
}

__global__ void __launch_bounds__(512, 2) fwd_mega(Args args) {
    extern __shared__ __attribute__((aligned(16))) unsigned char lds_raw[];
    LAS unsigned char* lds = (LAS unsigned char*)lds_raw;
    cg::grid_group grid = cg::this_grid();
    const int G = gridDim.x, bx = blockIdx.x;
    LAS unsigned long long* ptab = (LAS unsigned long long*)(lds + 147200);
    { const int tid = threadIdx.x;
    if (tid < 26) ptab[tid] = (unsigned long long)args.in[tid];
    if (tid == 26) ptab[26] = (unsigned long long)args.out;
    if (tid == 27) ptab[27] = (unsigned long long)args.ws;
    if (tid == 28) { ((volatile LAS unsigned*)(lds + 147200 + 240))[0] = 0u; ((volatile LAS unsigned*)(lds + 147200 + 240))[1] = 0u; } }
    __syncthreads();
    const bool coop = (args.ph_hi - args.ph_lo) > 1;
    XcdBarrier xbar; xbar.bar = (unsigned*)(args.ws + WS_CTL); xbar.x = 0; xbar.st = nullptr;
    if (coop) xbar = xcd_barrier_post((unsigned*)(args.ws + WS_CTL), (volatile LAS unsigned*)(lds + 147200 + 240));
#define INP(i) ((const float*)ldptr(ptab, (i)))
    for (int ph = args.ph_lo; ph < args.ph_hi; ++ph) {
    if (ph == 9) continue;
    const int tid = tid_now(), lane = tid & 63, wave = __builtin_amdgcn_readfirstlane(tid >> 6);
    const int gw = bx * 8 + wave, NGW = G * 8;
    unsigned char* ws = (unsigned char*)ldptr(ptab, 27); float* xres = (float*)ldptr(ptab, 26);
    bf16* Wgu1 = (bf16*)(ws + WS_WGU1); bf16* Wd1 = (bf16*)(ws + WS_WD1); bf16* Win = (bf16*)(ws + WS_WIN); bf16* Wout = (bf16*)(ws + WS_WOUT);
    bf16* Wq = (bf16*)(ws + WS_WQ); bf16* Wkv = (bf16*)(ws + WS_WKV); bf16* Wo = (bf16*)(ws + WS_WO); bf16* Wgu2 = (bf16*)(ws + WS_WGU2); bf16* Wd2 = (bf16*)(ws + WS_WD2);
    bf16* ACT = (bf16*)(ws + WS_R1); bf16* PROJ = (bf16*)(ws + WS_R1); bf16* Hb = (bf16*)(ws + WS_H)  ; bf16* ST = (bf16*)((unsigned char*)xres + 16 * MiB);
    bf16* MIX = (bf16*)(ws + WS_MIX); bf16* DST = (bf16*)(ws + WS_DST); bf16* MEMN = (bf16*)(ws + WS_MEMN); bf16* KVX = (bf16*)(ws + WS_KVX);
    bf16* OX = (bf16*)(ws + WS_OX);
    bf16* VTA = (bf16*)xres;
    bf16* VTG = (bf16*)(ws + WS_QX);
    float* SSQ = (float*)(ws + WS_SSQ); float* GLR = (float*)(ws + WS_GLR); float* DECAY = (float*)(ws + WS_DECAY); float* ROPE = (float*)(ws + WS_ROPE);
        if (ph == 0) {
            LAS float* scr = (LAS float*)(lds + wave * 17664);
            constexpr int I_G = 32 * 88, I_D = 88 * 32, I_IN = 32 * 97, I_OUT = 32 * 32, I_Q = 32 * 8, I_O = 8 * 32;
            constexpr int NIT = 3 * I_G + I_IN + I_OUT + 3 * I_Q + I_O; (void)I_D;
            for (int it = gw; it < NIT; it += NGW) {
                int r = it;
                if (r < I_G) { p0_tr(INP(3), DM, DFF, Wgu1, 256, 0, scr, r, lane, INP(2)); continue; } r -= I_G;
                if (r < I_G) { p0_tr(INP(4), DM, DFF, Wgu1, 256, 128, scr, r, lane, INP(2)); continue; } r -= I_G;
                if (r < I_IN) { p0_tr(INP(7), DM, MIXC, Win, 128, 0, scr, r, lane, INP(6)); continue; } r -= I_IN;
                if (r < I_OUT) { p0_tr(INP(13), DM, DM, Wout, 128, 0, scr, r, lane); continue; } r -= I_OUT;
                if (r < I_Q) { p0_tr(INP(16), DM, 512, Wq, 128, 0, scr, r, lane, INP(14)); continue; } r -= I_Q;
                if (r < I_Q) { p0_tr(INP(17), DM, 512, Wkv, 128, 0, scr, r, lane); continue; } r -= I_Q;
                if (r < I_Q) { p0_tr(INP(18), DM, 512, Wkv, 128, 512, scr, r, lane); continue; } r -= I_Q;
                if (r < I_O) { p0_tr(INP(21), 512, DM, Wo, 128, 0, scr, r, lane); continue; } r -= I_O;
                p0_tr(INP(24), DM, DFF, Wgu2, 256, 128, scr, r, lane, INP(22));
            }
            for (int idx = bx * 512 + tid; idx < SEQ * 64; idx += G * 512) { const int pos = idx >> 6, i = idx & 63;
                const float inv = exp2f(-(float)i * (13.287712379549449f / 64.0f)); const float ang = (float)pos * inv;
                const double rev = (double)ang * 0.15915494309189535; const float fr_ = (float)(rev - floor(rev));
                ROPE[idx] = __builtin_amdgcn_cosf(fr_); ROPE[SEQ * 64 + idx] = __builtin_amdgcn_sinf(fr_); }
            for (int m = gw; m < TOK + 4 * NMEM; m += NGW) {
                const bool ismem = m >= TOK; const float* src = ismem ? INP(1) + (size_t)(m - TOK) * DM : INP(0) + (size_t)m * DM;
                const float* gain = INP(15);
                f32x4 v[8]; float s = 0.f;
#pragma unroll
                for (int j = 0; j < 8; ++j) { v[j] = ismem ? *(const f32x4*)(src + 4 * lane + 256 * j) : __builtin_nontemporal_load((const f32x4*)(src + 4 * lane + 256 * j)); s += (v[j][0] * v[j][0] + v[j][1] * v[j][1]) + (v[j][2] * v[j][2] + v[j][3] * v[j][3]); }
                s = wave_sum(s);
                const float rs = ismem ? __builtin_amdgcn_rsqf(s * (1.f / 2048.f) + EPS) : 1.0f;
                bf16* dst = ismem ? MEMN + (size_t)(m - TOK) * DM : Hb + (size_t)m * DM;
#pragma unroll
                for (int j = 0; j < 8; ++j) { const f32x4 gv = ismem ? *(const f32x4*)(gain + 4 * lane + 256 * j) : (f32x4){1.f, 1.f, 1.f, 1.f};
                    u32x2 ov; ov.x = pk2(v[j][0] * rs * gv[0], v[j][1] * rs * gv[1]); ov.y = pk2(v[j][2] * rs * gv[2], v[j][3] * rs * gv[3]);
                    *(u32x2*)(dst + 4 * lane + 256 * j) = ov; }
                if (!ismem && lane < 32) SSQ[(size_t)m * 32 + lane] = (lane == 0) ? s : 0.f;
            }
        } else if (ph == 1 || ph == 12) {
            pg8::Gemm g{Hb, ph == 1 ? Wgu1 : Wgu2, TOK, 2 * DFF, DM}; pg8::StaticOrder S; S.init(TOK, 2 * DFF, G, bx);
            pg8::EpiSwiglu E{ACT, DFF, SSQ};
            pg8::gemm_phase<pg8::EpiSwiglu, pg8::StaticOrder, true, true>(lds, g, S, E);
            if (ph == 1) {
                __syncthreads();
                pg8::Gemm g2{MEMN, Wkv, 4 * NMEM, 1024, DM}; pg8::StaticOrder S2; S2.init(4 * NMEM, 1024, G, (bx + G - 128) % G);
                pg8::EpiScale E2{KVX, 1024, nullptr};
                pg8::gemm_phase<pg8::EpiScale, pg8::StaticOrder, true, true>(lds, g2, S2, E2);
            }
            { const int first = (ph == 1) ? 144 : 128;
              if (G == 256 && bx >= first) { __syncthreads(); LAS float* scr = (LAS float*)(lds + wave * 17664);
                  for (int it = (bx - first) * 8 + wave; it < 88 * 32; it += (256 - first) * 8) p0_tr(ph == 1 ? INP(5) : INP(25), DFF, DM, ph == 1 ? Wd1 : Wd2, 128, 0, scr, it, lane);
                  if (ph == 1) for (int it = (bx - first) * 8 + wave; it < 32 * 88; it += (256 - first) * 8) p0_tr(INP(23), DM, DFF, Wgu2, 256, 0, scr, it, lane, INP(22)); }
              else if (G != 256) { __syncthreads(); LAS float* scr = (LAS float*)(lds + wave * 17664);
                  for (int it = gw; it < 88 * 32; it += NGW) p0_tr(ph == 1 ? INP(5) : INP(25), DFF, DM, ph == 1 ? Wd1 : Wd2, 128, 0, scr, it, lane);
                  if (ph == 1) for (int it = gw; it < 32 * 88; it += NGW) p0_tr(INP(23), DM, DFF, Wgu2, 256, 0, scr, it, lane, INP(22)); } }
        } else if (ph == 2 || ph == 8 || ph == 11 || ph == 13) {
            const bf16* A = (ph == 2 || ph == 13) ? ACT : (ph == 8 ? MIX : OX);
            const bf16* Bt = ph == 2 ? Wd1 : (ph == 8 ? Wout : (ph == 11 ? Wo : Wd2));
            const int K = (ph == 2 || ph == 13) ? DFF : (ph == 8 ? DM : 512);
            pg8::Gemm g{A, Bt, TOK, DM, K}; pg8::StaticOrder S; S.init(TOK, DM, G, bx);
            pg8::EpiResid E{(const float*)nullptr  , Hb, ph == 13 ? xres : (float*)nullptr, ph == 13 ? nullptr : SSQ, (ph == 2 || ph == 13) ? 0.5f : 1.0f};
            pg8::gemm_phase<pg8::EpiResid, pg8::StaticOrder, true, true>(lds, g, S, E);
        } else if (ph == 3) {
            {
                pg8::Gemm g{Hb, Win, TOK, PROJW, DM};
                pg8::StaticOrder S; S.init(g.M, g.N, G, bx);
                pg8::EpiScale E{PROJ, PROJW, SSQ};
                pg8::gemm_phase<pg8::EpiScale, pg8::StaticOrder, true, true>(lds, g, S, E);
                __syncthreads();
            }
            if (ph == 3) {
                const int fr = lane & 15, fq = lane >> 4;
                LAS float* red = (LAS float*)lds;
                for (int rb = bx; rb < TOK / 32; rb += G) {
                    f32x4 a2[2] = {(f32x4){0.f, 0.f, 0.f, 0.f}, (f32x4){0.f, 0.f, 0.f, 0.f}};
#pragma unroll
                    for (int ks = 0; ks < 8; ++ks) { const int k = wave * 256 + 32 * ks + 8 * fq;
                        const bf16x8 wf = *(const bf16x8*)(Win + (size_t)(PROJW + fr) * DM + k);
#pragma unroll
                        for (int r2 = 0; r2 < 2; ++r2) { const bf16x8 hf = *(const bf16x8*)(Hb + (size_t)(rb * 32 + 16 * r2 + fr) * DM + k); MMA16(wf, hf, a2[r2]); } }
#pragma unroll
                    for (int r2 = 0; r2 < 2; ++r2) *(LAS f32x4*)(red + (wave * 32 + 16 * r2 + fr) * 16 + 4 * fq) = a2[r2];
                    __syncthreads();
                    { const int r = tid >> 4, c = tid & 15; float s = 0.f;
#pragma unroll
                      for (int ww = 0; ww < 8; ++ww) s += red[(ww * 32 + r) * 16 + c];
                      const int row = rb * 32 + r; float q = 0.f;
#pragma unroll
                      for (int e = 0; e < 32; ++e) q += SSQ[(size_t)row * 32 + e];
                      GLR[(size_t)row * 16 + c] = s * __builtin_amdgcn_rsqf(q * (1.f / 2048.f) + EPS); }
                    __syncthreads();
                }
            }
        } else if (ph == 4) {
            const float* qn = INP(8); const float* kn = INP(9);
            const int hs = lane >> 4, l = lane & 15;
#define PREP_ONE(p, a, b, cs, sn, hh) do { \
                    float x1[4] = {bflo(a.x), bfhi(a.x), bflo(a.y), bfhi(a.y)}, x2[4] = {bflo(b.x), bfhi(b.x), bflo(b.y), bfhi(b.y)}; \
                    float sq = 0.f; \
                    _Pragma("unroll") for (int e = 0; e < 4; ++e) sq += x1[e] * x1[e] + x2[e] * x2[e]; \
                    sq += __shfl_xor(sq, 1); sq += __shfl_xor(sq, 2); sq += __shfl_xor(sq, 4); sq += __shfl_xor(sq, 8); \
                    const float rs = __builtin_amdgcn_rsqf(sq * (1.f / 128.f) + EPS); \
                    const float* gn = ((hh) < 8) ? qn : kn; const float sc = ((hh) < 8) ? QSCALE : 1.0f; \
                    const f32x4 g1 = *(const f32x4*)(gn + 4 * l), g2 = *(const f32x4*)(gn + 64 + 4 * l); \
                    float o1[4], o2[4]; \
                    _Pragma("unroll") for (int e = 0; e < 4; ++e) { const float y1 = x1[e] * rs * g1[e], y2 = x2[e] * rs * g2[e]; o1[e] = (y1 * cs[e] - y2 * sn[e]) * sc; o2[e] = (y2 * cs[e] + y1 * sn[e]) * sc; } \
                    u32x2 oa, ob; oa.x = pk2(o1[0], o1[1]); oa.y = pk2(o1[2], o1[3]); ob.x = pk2(o2[0], o2[1]); ob.y = pk2(o2[2], o2[3]); \
                    *(u32x2*)(p) = oa; *(u32x2*)((p) + 64) = ob; } while (0)
#define PREP_LOAD(k, idx) const int row##k = (idx) >> 2, hh##k = ((idx) & 3) * 4 + hs, pos##k = row##k & (SEQ - 1); bf16* p##k = PROJ + (size_t)row##k * PROJW + hh##k * 128 + 4 * l; \
                    const u32x2 a##k = *(const u32x2*)p##k, b##k = *(const u32x2*)(p##k + 64); const f32x4 cs##k = *(const f32x4*)(ROPE + pos##k * 64 + 4 * l), sn##k = *(const f32x4*)(ROPE + SEQ * 64 + pos##k * 64 + 4 * l)
            int idx0 = gw;
            for (; idx0 + 3 * NGW < TOK * 4; idx0 += 4 * NGW) {
                PREP_LOAD(0, idx0); PREP_LOAD(1, idx0 + NGW); PREP_LOAD(2, idx0 + 2 * NGW); PREP_LOAD(3, idx0 + 3 * NGW);
                PREP_ONE(p0, a0, b0, cs0, sn0, hh0); PREP_ONE(p1, a1, b1, cs1, sn1, hh1); PREP_ONE(p2, a2, b2, cs2, sn2, hh2); PREP_ONE(p3, a3, b3, cs3, sn3, hh3);
            }
            for (; idx0 < TOK * 4; idx0 += NGW) { PREP_LOAD(0, idx0); PREP_ONE(p0, a0, b0, cs0, sn0, hh0); }
#undef PREP_ONE
#undef PREP_LOAD
            { LAS bf16* T = (LAS bf16*)lds; const int r = tid >> 3, j = tid & 7, dd = tid & 127, kq = tid >> 7;
              int idx = bx; u32x4 ta = {0u, 0u, 0u, 0u}, tb = {0u, 0u, 0u, 0u};
              if (idx < 2048) { const int rem = idx & 1023, b_ = rem >> 8, hq = (rem >> 5) & 7, st = rem & 31; const bf16* p = PROJ + (size_t)(b_ * SEQ + 64 * st + r) * PROJW + ((idx >> 10) ? 4096 : 2048) + 128 * hq + 8 * j;
                  ta = *(const u32x4*)p; tb = *(const u32x4*)(p + 64); }
              for (; idx < 2048; idx += G) {
                  *(LAS u32x4*)(T + r * QP + 8 * j) = ta; *(LAS u32x4*)(T + r * QP + 64 + 8 * j) = tb;
                  __syncthreads();
                  if (idx + G < 2048) { const int i2 = idx + G, rem = i2 & 1023, b_ = rem >> 8, hq = (rem >> 5) & 7, st = rem & 31; const bf16* p = PROJ + (size_t)(b_ * SEQ + 64 * st + r) * PROJW + ((i2 >> 10) ? 4096 : 2048) + 128 * hq + 8 * j;
                      ta = *(const u32x4*)p; tb = *(const u32x4*)(p + 64); }
                  unsigned v[16];
#pragma unroll
                  for (int i = 0; i < 16; ++i) { const int key = (idx >> 10) ? (16 * kq + i) : (32 * (kq >> 1) + 16 * ((i >> 2) & 1) + 8 * (kq & 1) + 4 * (i >> 3) + (i & 3)); v[i] = T[key * QP + dd]; }
                  u32x4 o0, o1; o0.x = v[0] | (v[1] << 16); o0.y = v[2] | (v[3] << 16); o0.z = v[4] | (v[5] << 16); o0.w = v[6] | (v[7] << 16);
                  o1.x = v[8] | (v[9] << 16); o1.y = v[10] | (v[11] << 16); o1.z = v[12] | (v[13] << 16); o1.w = v[14] | (v[15] << 16);
                  { const int rem = idx & 1023, b_ = rem >> 8, hq = (rem >> 5) & 7, st = rem & 31;
                    bf16* dst = ((idx >> 10) ? VTG : VTA) + ((size_t)(b_ * 8 + hq) * 128 + dd) * SEQ + 64 * st + 16 * kq;
                    *(u32x4*)dst = o0; *(u32x4*)(dst + 8) = o1; }
                  __syncthreads();
              } }
        } else if (ph == 5) {
            const float bref5 = attn_logit_bound(INP(8), INP(9), lane, 1.5849625007211562f);
            attn_build_bias(lds, tid, bref5);
            __syncthreads();
            for (int c0 = bx; c0 < 256; c0 += G) { const int c = (G == 256) ? ((c0 & 7) * 32 + (c0 >> 3)) : c0;
                const int bh = c >> 3, s = c & 7, bb = bh >> 3, hh = bh & 7;
#pragma unroll 1
                for (int k = 0; k < 2; ++k) { const int qb = k == 0 ? s : 15 - s; const int q0 = qb * 128; const size_t R0 = (size_t)bb * SEQ;
                    attn_item<0>(lds, PROJ + (R0 + q0) * PROJW + hh * 128, PROJW, PROJ + R0 * PROJW + 1024 + hh * 128, VTA + (size_t)(bb * 8 + hh) * 128 * SEQ, PROJW,
                                 (q0 + 128) / 64, q0, MIX + (R0 + q0) * DM + hh * 128, DM, nullptr, nullptr, nullptr, nullptr, 0, bref5);
                    __syncthreads(); } }
            for (int item = bx; item < 512; item += G) gla_stepA(lds, item, PROJ, VTG, GLR, INP(10), INP(11), DST, DECAY);
        } else if (ph == 6) {
            for (int idx = bx * 512 + tid; idx < 16 * 256 * 32; idx += G * 512) { const int bh = idx >> 13, rem = idx & 8191;
                f32x4 st = (f32x4){0.f, 0.f, 0.f, 0.f};
#pragma unroll
                for (int n = 0; n < 32; ++n) { const size_t item = (size_t)bh * 32 + n;
                    const u32x2 dsv = *(const u32x2*)(DST + item * 32768 + (size_t)rem * 4); const f32x4 dc = *(const f32x4*)(DECAY + item * 128 + (rem & 31) * 4);
                    u32x2 ov; ov.x = pk2(st[0], st[1]); ov.y = pk2(st[2], st[3]); *(u32x2*)(ST + item * 32768 + (size_t)rem * 4) = ov;
                    st[0] = dc[0] * st[0] + bflo(dsv.x); st[1] = dc[1] * st[1] + bfhi(dsv.x); st[2] = dc[2] * st[2] + bflo(dsv.y); st[3] = dc[3] * st[3] + bfhi(dsv.y); } }
        } else if (ph == 7) {
            for (int item = bx; item < 512; item += G) gla_stepC(lds, item, PROJ, VTG, GLR, INP(10), INP(11), ST, INP(12), MIX);
        } else if (ph == 10) {
            const float bref10 = attn_logit_bound(INP(19), INP(20), lane, 0.f);
            for (int item = bx; item < 256; item += G) { const int bb = item >> 6, hh = (item >> 4) & 3, qb = item & 15; const size_t R0 = (size_t)bb * SEQ + qb * 128;
                attn_item<2>(lds, Hb + R0 * DM, DM, KVX + (size_t)bb * NMEM * 1024 + hh * 128, KVX + (size_t)bb * NMEM * 1024 + 512 + hh * 128, 1024,
                             4, 0, OX + R0 * 512 + hh * 128, 512, INP(19), INP(20), Wq + (size_t)hh * 128 * DM, SSQ, (int)R0, bref10);
                __syncthreads(); }
        }
        if (ph + 1 < args.ph_hi) { if (args.ph_lo < 0) grid.sync();   xcd_barrier(xbar); }
    }
}

#ifndef MK_PER_PHASE
#define MK_PER_PHASE 0
#endif
extern "C" void kernel_launch(void* const* d_in, const int* in_sizes, int n_in, void* d_out, int out_size, void* d_ws, size_t ws_size, hipStream_t stream) {
    static int grid = 0;
    if (grid == 0) {
        if (n_in != 26 || out_size != TOK * DM || ws_size < WS_END) { fprintf(stderr, "kernel_launch: unexpected problem (n_in %d out %d ws %zu)\n", n_in, out_size, ws_size); grid = -1; return; }
        int dev = 0, cus = 0, per_cu = 0;
        (void)hipGetDevice(&dev); (void)hipDeviceGetAttribute(&cus, hipDeviceAttributeMultiprocessorCount, dev);
        if (hipFuncSetAttribute((const void*)fwd_mega, hipFuncAttributeMaxDynamicSharedMemorySize, LDS_BYTES) != hipSuccess) { fprintf(stderr, "kernel_launch: hipFuncSetAttribute failed\n"); grid = -1; return; }
        if (hipOccupancyMaxActiveBlocksPerMultiprocessor(&per_cu, (const void*)fwd_mega, 512, LDS_BYTES) != hipSuccess || per_cu < 1) { fprintf(stderr, "kernel_launch: occupancy query says %d\n", per_cu); per_cu = 1; }
        (void)hipGetLastError();
        grid = cus * 1;
        if (per_cu < 1) grid = -1;
    }
    if (grid < 0) return;
    if (hipMemsetAsync((char*)d_ws + WS_CTL, 0, CTL_ZERO_BYTES, stream) != hipSuccess) { fprintf(stderr, "kernel_launch: memset of barrier words failed\n"); return; }
    Args a{};
    for (int i = 0; i < 26; ++i) a.in[i] = (const float*)d_in[i];
    a.out = (float*)d_out; a.ws = (unsigned char*)d_ws;
#if MK_PER_PHASE
    for (int ph = 0; ph < NPHASE; ++ph) { a.ph_lo = ph; a.ph_hi = ph + 1; hipLaunchKernelGGL(fwd_mega, dim3(grid), dim3(512), LDS_BYTES, stream, a); }
#else
    a.ph_lo = 0; a.ph_hi = NPHASE;
    void* kargs[] = {&a};
    hipError_t e = hipLaunchCooperativeKernel((const void*)fwd_mega, dim3(grid), dim3(512), kargs, LDS_BYTES, stream);
    if (e != hipSuccess) fprintf(stderr, "cooperative launch failed: %s (grid %d)\n", hipGetErrorString(e), grid);
#endif
}
```
